# Optimizing an MI355X kernel written in HIP

```python
import math
import jax
import jax.numpy as jnp
from jax import lax
import numpy as np


D_MODEL = 2048
BATCH = 2
SEQ = 8192
DEPTH = 4

CTX_LEN = 256
GRID_W = 64
HEAD_DIM = 64
ROPE_BASE = 10000.0
EPS = 1e-6
NEG_INF = -1e30

A_HEADS = D_MODEL // 512
A_WIDTH = A_HEADS * 2 * HEAD_DIM
B_HEADS = D_MODEL // 256
B_KV_HEADS = B_HEADS // 4
B_WIDTH = B_HEADS * HEAD_DIM
B_KV_WIDTH = B_KV_HEADS * HEAD_DIM
WINDOW = 128
BLOCK = 128
POOL_WINDOWS = (2, 4, 8, 16)
C_WIDTH = D_MODEL // 4
C_GROUP = C_WIDTH // len(POOL_WINDOWS)
D_WIDTH = D_MODEL - A_WIDTH - B_WIDTH - C_WIDTH
HY_EMB = 33
HY_HIDDEN = 64
HY_FAST_DECAY = 0.3
HY_SLOW_DECAY = 1.5
HY_TARGET = 1e-2

MIX_WIDTH = A_WIDTH + B_WIDTH + C_WIDTH + D_WIDTH
FFN_HIDDEN = ((8 * D_MODEL // 3 + 255) // 256) * 256

OFF_QA = 0
OFF_KA = OFF_QA + A_WIDTH
OFF_VA = OFF_KA + A_WIDTH
OFF_QB = OFF_VA + A_WIDTH
OFF_KB = OFF_QB + B_WIDTH
OFF_VB = OFF_KB + B_KV_WIDTH
OFF_POOL = OFF_VB + B_KV_WIDTH
OFF_HY = OFF_POOL + C_WIDTH
IN_COLS = OFF_HY + 3 * D_WIDTH

kernel_name = 'hybrid_parallel_mixer_dit_trunk'


def rms_norm(x, g):
    xf = x.astype(jnp.float32)
    y = xf * lax.rsqrt(jnp.mean(xf * xf, axis=-1, keepdims=True) + EPS)
    return (y * g.astype(jnp.float32)).astype(x.dtype)


def axial_rope_tables(L):
    rows = L // GRID_W
    row = jnp.repeat(jnp.arange(rows, dtype=jnp.float32), GRID_W)
    col = jnp.tile(jnp.arange(GRID_W, dtype=jnp.float32), rows)
    half = HEAD_DIM // 2
    inv = ROPE_BASE ** (-jnp.arange(0, half, 2, dtype=jnp.float32) / half)
    ang = jnp.concatenate([row[:, None] * inv, col[:, None] * inv], axis=-1)
    return jnp.cos(ang), jnp.sin(ang)


def apply_axial_rope(x, cos, sin):
    shp = x.shape
    nf = HEAD_DIM // 4
    xr = x.reshape(shp[0], shp[1], -1, 2, 2, nf).astype(jnp.float32)
    x1, x2 = xr[..., 0, :], xr[..., 1, :]
    c = cos.reshape(shp[1], 1, 2, nf)
    s = sin.reshape(shp[1], 1, 2, nf)
    out = jnp.stack([x1 * c - x2 * s, x2 * c + x1 * s], axis=-2)
    return out.reshape(shp).astype(x.dtype)


def dwconv3(u, w, b):
    up = jnp.pad(u, ((0, 0), (1, 1), (0, 0)))
    return up[:, :-2] * w[0] + up[:, 1:-1] * w[1] + up[:, 2:] * w[2] + b


def band_blocks(t, nb):
    L = t.shape[1]
    tp = jnp.pad(t, [(0, 0), (BLOCK, BLOCK)] + [(0, 0)] * (t.ndim - 2))
    parts = [tp[:, i * BLOCK: i * BLOCK + L].reshape((t.shape[0], nb, BLOCK) + t.shape[2:]) for i in range(3)]
    return jnp.concatenate(parts, axis=2)


def diff_attention(qa, ka, va, qa_c, ka_c, va_c, lam, sub_g, sub_scale):
    B, L = qa.shape[:2]
    nb = L // BLOCK
    k_all = jnp.concatenate([ka_c, ka], axis=1)
    v_all = jnp.concatenate([va_c, va], axis=1)

    def attend(q, k, v):
        s = jnp.einsum('bqhid,bkhid->bhiqk', q, k).astype(jnp.float32) * (HEAD_DIM ** -0.5)
        p = jax.nn.softmax(s, axis=-1)
        a = p[:, :, 0] - lam * p[:, :, 1]
        o = jnp.einsum('bhqk,bkhe->bqhe', a.astype(v.dtype), v)
        return rms_norm(o, sub_g) * sub_scale

    q_blocks = jnp.moveaxis(qa.reshape((B, nb, BLOCK) + qa.shape[2:]), 1, 0)
    o = lax.map(lambda qb: attend(qb, k_all, v_all), q_blocks)
    o = jnp.moveaxis(o, 0, 1).reshape(B, L, A_WIDTH)
    o_c = None
    if qa_c is not None:
        o_c = attend(qa_c, ka_c, va_c).reshape(B, qa_c.shape[1], A_WIDTH)
    return o, o_c


def window_attention(qb, kb, vb, qb_c, kb_c, vb_c, sink):
    B, L = qb.shape[:2]
    C = kb_c.shape[1]
    nb = L // BLOCK
    G = B_HEADS // B_KV_HEADS
    scale = HEAD_DIM ** -0.5
    sink_f = sink.astype(jnp.float32).reshape(B_KV_HEADS, G)

    def with_sink(s):
        sb = jnp.broadcast_to(sink_f[:, :, None, None], s.shape[:-1] + (1,))
        return sb

    qblk = qb.reshape(B, nb, BLOCK, B_KV_HEADS, G, HEAD_DIM)
    kband = band_blocks(kb, nb)
    vband = band_blocks(vb, nb)
    qpos = jnp.arange(L).reshape(nb, BLOCK)
    kpos = jnp.arange(nb)[:, None] * BLOCK - BLOCK + jnp.arange(3 * BLOCK)[None, :]
    valid = (kpos[:, None, :] >= 0) & (kpos[:, None, :] < L) & (jnp.abs(kpos[:, None, :] - qpos[:, :, None]) <= WINDOW)
    s_loc = jnp.einsum('bnqkgd,bnjkd->bnkgqj', qblk, kband).astype(jnp.float32) * scale
    s_loc = jnp.where(valid[None, :, None, None], s_loc, NEG_INF)
    s_ctx = jnp.einsum('bnqkgd,bjkd->bnkgqj', qblk, kb_c).astype(jnp.float32) * scale
    p = jax.nn.softmax(jnp.concatenate([with_sink(s_loc), s_ctx, s_loc], axis=-1), axis=-1)
    o = (jnp.einsum('bnkgqj,bjkd->bnqkgd', p[..., 1:1 + C].astype(vb.dtype), vb_c)
         + jnp.einsum('bnkgqj,bnjkd->bnqkgd', p[..., 1 + C:].astype(vb.dtype), vband))
    o = o.reshape(B, L, B_WIDTH)
    o_c = None
    if qb_c is not None:
        qc = qb_c.reshape(B, C, B_KV_HEADS, G, HEAD_DIM)
        s_c = jnp.einsum('bqkgd,bjkd->bkgqj', qc, kb_c).astype(jnp.float32) * scale
        p_c = jax.nn.softmax(jnp.concatenate([with_sink(s_c), s_c], axis=-1), axis=-1)
        o_c = jnp.einsum('bkgqj,bjkd->bqkgd', p_c[..., 1:].astype(vb_c.dtype), vb_c).reshape(B, C, B_WIDTH)
    return o, o_c


def pool_mixer(u, w_lin, ls):
    B, L, _ = u.shape
    cs = jnp.concatenate([jnp.zeros_like(u[:, :1], dtype=jnp.float32),
                          jnp.cumsum(u.astype(jnp.float32), axis=1)], axis=1)
    t = jnp.arange(L)
    outs = []
    for g, w in enumerate(POOL_WINDOWS):
        lo = w // 2
        hi = w - 1 - lo
        start = jnp.clip(t - lo, 0, L)
        end = jnp.clip(t + hi + 1, 0, L)
        csg = cs[..., g * C_GROUP:(g + 1) * C_GROUP]
        mean = (csg[:, end] - csg[:, start]) / (end - start).astype(jnp.float32)[None, :, None]
        outs.append(mean.astype(u.dtype) - u[..., g * C_GROUP:(g + 1) * C_GROUP])
    d = jnp.stack(outs, axis=2)
    y = jnp.einsum('blgc,gcd->blgd', d, w_lin).reshape(B, L, C_WIDTH)
    return y * ls


def hyena_kernel(L, w1, b1, w2, b2, w3, freq):
    t01 = jnp.linspace(0.0, 1.0, L, dtype=jnp.float32)[:, None]
    bands = (HY_EMB - 1) // 2
    w_ang = 2.0 * math.pi * jnp.arange(L, dtype=jnp.float32)[:, None] / L
    f = jnp.linspace(1e-4, bands - 1, bands, dtype=jnp.float32)[None, :]
    z = jnp.concatenate([t01, jnp.cos(f * w_ang), -jnp.sin(f * w_ang)], axis=-1)
    h = jnp.sin(freq * (z @ w1 + b1))
    h = jnp.sin(freq * (h @ w2 + b2))
    h = (h @ w3).astype(jnp.float32).reshape(L, 2, D_WIDTH)
    deltas = jnp.linspace(math.log(HY_TARGET) / HY_FAST_DECAY, math.log(HY_TARGET) / HY_SLOW_DECAY, D_WIDTH, dtype=jnp.float32)
    h = h * jnp.exp(-t01 * jnp.abs(deltas)[None, :])[:, None, :]
    kern = jnp.concatenate([h[:, 0], jnp.zeros((1, D_WIDTH), jnp.float32), h[:0:-1, 1]], axis=0)
    return kern * lax.rsqrt(jnp.sum(kern * kern, axis=0, keepdims=True) + EPS)


def long_conv(u, kern):
    L = u.shape[1]
    uf = jnp.fft.rfft(u.astype(jnp.float32), n=2 * L, axis=1)
    kf = jnp.fft.rfft(kern, n=2 * L, axis=0)
    return jnp.fft.irfft(uf * kf[None], n=2 * L, axis=1)[:, :L].astype(u.dtype)


def hyena_mixer(u, conv_w, conv_b, kern, bias):
    u = dwconv3(u, conv_w, conv_b)
    v, x1, x2 = jnp.split(u, 3, axis=-1)
    z = v * x1
    z = long_conv(z, kern) + z * bias
    return x2 * z


def conv_ffn(h, w_up, conv_w, conv_b, w_down):
    u = dwconv3(h @ w_up, conv_w, conv_b)
    gate, up = jnp.split(u, 2, axis=-1)
    return (jax.nn.silu(gate) * up) @ w_down


def setup_inputs(seed: int = 0) -> dict:
    key = jax.random.key(seed)
    ks = jax.random.split(key, 29)

    def nrm(k, shape, scale):
        return jax.random.normal(k, shape, jnp.float32) * scale

    return {
        'x': nrm(ks[0], (BATCH, SEQ, D_MODEL), 1.0),
        'c': nrm(ks[1], (BATCH, D_MODEL), 1.0),
        'ctx': nrm(ks[2], (BATCH, CTX_LEN, D_MODEL), 1.0),
        'c_ctx': nrm(ks[3], (D_MODEL,), 1.0),
        'w_mod': nrm(ks[4], (DEPTH, D_MODEL, 6 * D_MODEL), 0.5 * D_MODEL ** -0.5),
        'b_mod': nrm(ks[5], (DEPTH, 6 * D_MODEL), 0.01),
        'norm1_g': 1.0 + nrm(ks[6], (DEPTH, D_MODEL), 0.05),
        'norm2_g': 1.0 + nrm(ks[7], (DEPTH, D_MODEL), 0.05),
        'w_in': nrm(ks[8], (DEPTH, D_MODEL, IN_COLS), D_MODEL ** -0.5),
        'w_out': nrm(ks[9], (DEPTH, MIX_WIDTH, D_MODEL), MIX_WIDTH ** -0.5),
        'qk_gain': 1.0 + nrm(ks[10], (DEPTH, 4, HEAD_DIM), 0.05),
        'diff_lam': nrm(ks[11], (DEPTH, 4, HEAD_DIM), 0.1),
        'diff_subln': 1.0 + nrm(ks[12], (DEPTH, 2 * HEAD_DIM), 0.05),
        'win_sink': nrm(ks[13], (DEPTH, B_HEADS), 1.0),
        'pool_w': nrm(ks[14], (DEPTH, len(POOL_WINDOWS), C_GROUP, C_GROUP), C_GROUP ** -0.5),
        'pool_scale': 1.0 + nrm(ks[15], (DEPTH, C_WIDTH), 0.1),
        'hy_conv_w': nrm(ks[16], (DEPTH, 3, 3 * D_WIDTH), 3 ** -0.5),
        'hy_conv_b': nrm(ks[17], (DEPTH, 3 * D_WIDTH), 0.01),
        'hy_w1': nrm(ks[18], (DEPTH, HY_EMB, HY_HIDDEN), HY_EMB ** -0.5),
        'hy_b1': nrm(ks[19], (DEPTH, HY_HIDDEN), 0.1),
        'hy_w2': nrm(ks[20], (DEPTH, HY_HIDDEN, HY_HIDDEN), HY_HIDDEN ** -0.5),
        'hy_b2': nrm(ks[21], (DEPTH, HY_HIDDEN), 0.1),
        'hy_w3': nrm(ks[22], (DEPTH, HY_HIDDEN, 2 * D_WIDTH), HY_HIDDEN ** -0.5),
        'hy_freq': 1.0 + nrm(ks[23], (DEPTH, HY_HIDDEN), 0.1),
        'hy_bias': nrm(ks[24], (DEPTH, D_WIDTH), 0.5),
        'ffn_w_in': nrm(ks[25], (DEPTH, D_MODEL, 2 * FFN_HIDDEN), D_MODEL ** -0.5),
        'ffn_conv_w': nrm(ks[26], (DEPTH, 3, 2 * FFN_HIDDEN), 3 ** -0.5),
        'ffn_conv_b': nrm(ks[27], (DEPTH, 2 * FFN_HIDDEN), 0.01),
        'ffn_w_out': nrm(ks[28], (DEPTH, FFN_HIDDEN, D_MODEL), FFN_HIDDEN ** -0.5),
    }


def reference(x, c, ctx, c_ctx, w_mod, b_mod, norm1_g, norm2_g, w_in, w_out, qk_gain, diff_lam, diff_subln,
              win_sink, pool_w, pool_scale, hy_conv_w, hy_conv_b, hy_w1, hy_b1, hy_w2, hy_b2, hy_w3, hy_freq,
              hy_bias, ffn_w_in, ffn_conv_w, ffn_conv_b, ffn_w_out):
    B, L, _ = x.shape
    C = ctx.shape[1]
    cos, sin = axial_rope_tables(L)
    for l in range(DEPTH):
        last = l == DEPTH - 1
        wl = w_in[l]
        mod = jax.nn.silu(c) @ w_mod[l] + b_mod[l]
        mod_c = jax.nn.silu(c_ctx) @ w_mod[l] + b_mod[l]
        sh1, sc1, g1, sh2, sc2, g2 = jnp.split(mod[:, None, :], 6, axis=-1)
        csh1, csc1, cg1, csh2, csc2, cg2 = jnp.split(mod_c, 6, axis=-1)

        h = rms_norm(x, norm1_g[l]) * (1.0 + sc1) + sh1
        hc = rms_norm(ctx, norm1_g[l]) * (1.0 + csc1) + csh1
        p = h @ wl
        if last:
            pkv_a = hc @ wl[:, OFF_KA:OFF_QB]
            pkv_b = hc @ wl[:, OFF_KB:OFF_POOL]
            ka_c_raw, va_c_raw = pkv_a[..., :A_WIDTH], pkv_a[..., A_WIDTH:]
            kb_c_raw, vb_c_raw = pkv_b[..., :B_KV_WIDTH], pkv_b[..., B_KV_WIDTH:]
            pc = None
        else:
            pc = hc @ wl
            ka_c_raw, va_c_raw = pc[..., OFF_KA:OFF_VA], pc[..., OFF_VA:OFF_QB]
            kb_c_raw, vb_c_raw = pc[..., OFF_KB:OFF_VB], pc[..., OFF_VB:OFF_POOL]

        qa = apply_axial_rope(rms_norm(p[..., OFF_QA:OFF_KA].reshape(B, L, A_HEADS, 2, HEAD_DIM), qk_gain[l, 0]), cos, sin)
        ka = apply_axial_rope(rms_norm(p[..., OFF_KA:OFF_VA].reshape(B, L, A_HEADS, 2, HEAD_DIM), qk_gain[l, 1]), cos, sin)
        va = p[..., OFF_VA:OFF_QB].reshape(B, L, A_HEADS, 2 * HEAD_DIM)
        ka_c = rms_norm(ka_c_raw.reshape(B, C, A_HEADS, 2, HEAD_DIM), qk_gain[l, 1])
        va_c = va_c_raw.reshape(B, C, A_HEADS, 2 * HEAD_DIM)
        qa_c = None if last else rms_norm(pc[..., OFF_QA:OFF_KA].reshape(B, C, A_HEADS, 2, HEAD_DIM), qk_gain[l, 0])
        lam_p = diff_lam[l].astype(jnp.float32)
        lambda_init = 0.8 - 0.6 * math.exp(-0.3 * l)
        lam = jnp.exp(jnp.sum(lam_p[0] * lam_p[1])) - jnp.exp(jnp.sum(lam_p[2] * lam_p[3])) + lambda_init
        o_a, o_a_c = diff_attention(qa, ka, va, qa_c, ka_c, va_c, lam, diff_subln[l], 1.0 - lambda_init)

        qb = apply_axial_rope(rms_norm(p[..., OFF_QB:OFF_KB].reshape(B, L, B_HEADS, HEAD_DIM), qk_gain[l, 2]), cos, sin)
        kb = apply_axial_rope(rms_norm(p[..., OFF_KB:OFF_VB].reshape(B, L, B_KV_HEADS, HEAD_DIM), qk_gain[l, 3]), cos, sin)
        vb = p[..., OFF_VB:OFF_POOL].reshape(B, L, B_KV_HEADS, HEAD_DIM)
        kb_c = rms_norm(kb_c_raw.reshape(B, C, B_KV_HEADS, HEAD_DIM), qk_gain[l, 3])
        vb_c = vb_c_raw.reshape(B, C, B_KV_HEADS, HEAD_DIM)
        qb_c = None if last else rms_norm(pc[..., OFF_QB:OFF_KB].reshape(B, C, B_HEADS, HEAD_DIM), qk_gain[l, 2])
        o_b, o_b_c = window_attention(qb, kb, vb, qb_c, kb_c, vb_c, win_sink[l])

        o_c = pool_mixer(p[..., OFF_POOL:OFF_HY], pool_w[l], pool_scale[l])

        kern_lat = hyena_kernel(L, hy_w1[l], hy_b1[l], hy_w2[l], hy_b2[l], hy_w3[l], hy_freq[l])
        o_d = hyena_mixer(p[..., OFF_HY:], hy_conv_w[l], hy_conv_b[l], kern_lat, hy_bias[l])

        x = x + g1 * (jnp.concatenate([o_a, o_b, o_c, o_d], axis=-1) @ w_out[l])
        h2 = rms_norm(x, norm2_g[l]) * (1.0 + sc2) + sh2
        x = x + g2 * conv_ffn(h2, ffn_w_in[l], ffn_conv_w[l], ffn_conv_b[l], ffn_w_out[l])

        if not last:
            o_c_c = pool_mixer(pc[..., OFF_POOL:OFF_HY], pool_w[l], pool_scale[l])
            kern_ctx = hyena_kernel(C, hy_w1[l], hy_b1[l], hy_w2[l], hy_b2[l], hy_w3[l], hy_freq[l])
            o_d_c = hyena_mixer(pc[..., OFF_HY:], hy_conv_w[l], hy_conv_b[l], kern_ctx, hy_bias[l])
            ctx = ctx + cg1 * (jnp.concatenate([o_a_c, o_b_c, o_c_c, o_d_c], axis=-1) @ w_out[l])
            hc2 = rms_norm(ctx, norm2_g[l]) * (1.0 + csc2) + csh2
            ctx = ctx + cg2 * conv_ffn(hc2, ffn_w_in[l], ffn_conv_w[l], ffn_conv_b[l], ffn_w_out[l])
    return x
```

```cpp
#include <hip/hip_runtime.h>
#include <cstdio>
#include <cstdint>
namespace pg8 {
#define PG8_LAS __attribute__((address_space(3)))
typedef unsigned short bf16_t;
typedef short bf16x8 __attribute__((ext_vector_type(8)));
typedef float f32x4 __attribute__((ext_vector_type(4)));
typedef unsigned u32x4 __attribute__((ext_vector_type(4)));
constexpr int BM = 256, BK = 64, HALF = 128, HTB = HALF * BK * 2  , STAGE_BYTES = 8 * HTB, NXCD = 8, WGM = 8;

__host__ __device__ __forceinline__ int lds_byte(int r, int c) { const int st = (r >> 4) * 2 + (c >> 5), rr = r & 15, cc = c & 31, ob = rr * 64 + cc * 2; return st * 1024 + (ob ^ (((ob >> 9) & 1) << 5)); }
__host__ __device__ __forceinline__ void stage_rc(int b, int& R, int& C) { const int st = b / 1024, sb = b % 1024, swz = sb ^ (((sb >> 9) & 1) << 5); R = (st >> 1) * 16 + swz / 64; C = (st & 1) * 32 + (swz % 64) / 2; }
__host__ __device__ __forceinline__ int perm32(int rho) { const int n = rho >> 4, i = rho & 15; return 8 * (i >> 2) + 4 * n + (i & 3); }

struct Unit { int pm, pn; };
struct Gemm { const bf16_t* A; const bf16_t* Bt; int M, N, K; };

struct StaticOrder {
    int nM, nN, nwg, G, c;
    __host__ __device__ void init(int M, int N, int G_, int c_) { nM = M / BM; nN = N / BM; nwg = nM * nN; G = G_; c = c_; }
    __host__ __device__ bool next(int i, Unit& u) const {
        const long L = (long)i * G + c; if (L >= nwg) return false;
        int wgid = (int)L; { const int q = nwg / NXCD, r = nwg % NXCD, xcd = wgid % NXCD, off = wgid / NXCD; wgid = (xcd < r ? xcd * (q + 1) : r * (q + 1) + (xcd - r) * q) + off; }
        const int nig = WGM * nN, gid = wgid / nig, fm = gid * WGM, gsz = (nM - fm) < WGM ? (nM - fm) : WGM;
        u.pm = fm + ((wgid % nig) % gsz); u.pn = (wgid % nig) / gsz; return true;
    }
    __device__ __forceinline__ void a_ready(const Unit&) const {}
    __device__ __forceinline__ void done(const Unit&) const {}
};

__device__ __forceinline__ unsigned cvt_pk_bf16(float lo, float hi) { unsigned r; asm volatile("v_cvt_pk_bf16_f32 %0, %1, %2" : "=v"(r) : "v"(lo), "v"(hi)); return r; }
typedef float f32x2 __attribute__((ext_vector_type(2)));
__device__ __forceinline__ f32x2 gelu_pk(f32x2 v) {
    const f32x2 av = __builtin_elementwise_abs(v), d = av * 0.2316418882f + 1.0f;
    f32x2 t; t.x = __builtin_amdgcn_rcpf(d.x); t.y = __builtin_amdgcn_rcpf(d.y);
    f32x2 q = t * 0.5307027145f + (-0.7265760135f); q = q * t + 0.7107068705f; q = q * t + (-0.142248368f); q = q * t + 0.127414796f; q = q * t;
    const f32x2 s = (v * v) * (-0.72134752044f);
    f32x2 e; e.x = __builtin_amdgcn_exp2f(s.x); e.y = __builtin_amdgcn_exp2f(s.y);
    const f32x2 m = v * (q * e), r = v - m;
    f32x2 o; o.x = v.x < 0.f ? m.x : r.x; o.y = v.y < 0.f ? m.y : r.y; return o;
}

template <int ACT  > struct EpiBf16 {
    static constexpr bool PERM = true, AFTER_DRAIN = false; static_assert(ACT == 0 || ACT == 1, "EpiBf16: ACT is 0 (none) or 1 (gelu_pk)");
    bf16_t* O; int ldc; const float* bias; int split_cols; size_t split_stride; float scale0;
    __device__ __forceinline__ void operator()(const f32x4 (&acc)[2][2][4][2], const Unit& u, int wr, int wc, int fr, int fq) const {
        const int row0 = u.pm * BM + wr * 64 + fr; int colt = u.pn * BM; bf16_t* base = O;
        float sc = 1.f; if (split_cols) { const int t = colt / split_cols; base += (size_t)t * split_stride; colt -= t * split_cols; if (t == 0) sc = scale0; }
        const int col0 = colt + wc * 32 + 8 * fq, bcol0 = u.pn * BM + wc * 32 + 8 * fq;
        f32x4 bv[2][2];
#pragma unroll
        for (int bj = 0; bj < 2; ++bj)
#pragma unroll
            for (int n = 0; n < 2; ++n) bv[bj][n] = bias ? *(const f32x4*)(bias + bcol0 + bj * HALF + 4 * n) : (f32x4){0.f, 0.f, 0.f, 0.f};
#pragma unroll
        for (int ai = 0; ai < 2; ++ai)
#pragma unroll
            for (int m = 0; m < 4; ++m) { bf16_t* rowp = base + (size_t)(row0 + ai * HALF + m * 16) * ldc + col0;
#pragma unroll
                for (int bj = 0; bj < 2; ++bj) { f32x4 v0 = acc[ai][bj][m][0] + bv[bj][0], v1 = acc[ai][bj][m][1] + bv[bj][1];
                    if (ACT == 1) { f32x2 a = gelu_pk((f32x2){v0[0], v0[1]}), b = gelu_pk((f32x2){v0[2], v0[3]}), c = gelu_pk((f32x2){v1[0], v1[1]}), d = gelu_pk((f32x2){v1[2], v1[3]});
                        v0 = (f32x4){a.x, a.y, b.x, b.y}; v1 = (f32x4){c.x, c.y, d.x, d.y}; }
                    v0 = v0 * sc; v1 = v1 * sc; u32x4 w; w.x = cvt_pk_bf16(v0[0], v0[1]); w.y = cvt_pk_bf16(v0[2], v0[3]); w.z = cvt_pk_bf16(v1[0], v1[1]); w.w = cvt_pk_bf16(v1[2], v1[3]);
                    *(u32x4*)(rowp + bj * HALF) = w; } }
    }
};

template <class Epi, class Sched, bool ALIGN_EPI = false, bool SP2 = false, bool SWAP = false>
__device__ __forceinline__ void gemm_phase(PG8_LAS unsigned char* lds, const Gemm g, const Sched& S, const Epi& E) {
    int tid_ = threadIdx.x; asm volatile("" : "+v"(tid_));
    const int tid = tid_, wid = __builtin_amdgcn_readfirstlane(tid >> 6), lane = tid & 63, wr = wid >> 2, wc = wid & 3, fr = lane & 15, fq = lane >> 4;
    const int K = g.K, nt = K / BK;
    unsigned voffA[2], voffB[2];
#pragma unroll
    for (int i = 0; i < 2; ++i) { int R, C; stage_rc(tid * 16 + i * 8192, R, C); const int Rb = Epi::PERM ? ((R & ~31) + perm32(R & 31)) : R;
        voffA[i] = (unsigned)(R * K + C) * 2u; voffB[i] = (unsigned)(Rb * K + C) * 2u; }
    const size_t kstep = (size_t)(BK * 2);
    const size_t hstep = (size_t)HALF * K * 2;
    const size_t tstep = 2 * hstep;
    const unsigned ldsw = (unsigned)wid * 1024u;
    const int aoff = lds_byte(wr * 64 + fr, fq * 8), boff = lds_byte(wc * 32 + fr, fq * 8);
#define PG8_SA(b, h) (((b) * 2 + (h)) * HTB)
#define PG8_SB(b, h) ((4 + (b) * 2 + (h)) * HTB)
#define PG8_STAGE(bufoff, gbase, voff) do { _Pragma("unroll") for (int _i = 0; _i < 2; ++_i) \
        __builtin_amdgcn_global_load_lds((const unsigned*)((const char*)(gbase) + (voff)[_i]), (PG8_LAS unsigned*)(lds + (bufoff) + ldsw + _i * 8192), 16, 0, 0); } while (0)
#define PG8_LDA(dst, b, h) do { _Pragma("unroll") for (int m = 0; m < 4; ++m) _Pragma("unroll") for (int k = 0; k < 2; ++k) dst[m][k] = *(const PG8_LAS bf16x8*)(lds + PG8_SA(b, h) + aoff + m * 2048 + k * 1024); } while (0)
#define PG8_LDB(dst, b, h) do { _Pragma("unroll") for (int n = 0; n < 2; ++n) _Pragma("unroll") for (int k = 0; k < 2; ++k) dst[n][k] = *(const PG8_LAS bf16x8*)(lds + PG8_SB(b, h) + boff + n * 2048 + k * 1024); } while (0)
#define PG8_MMA(ai, bj, At, Bt) do { __builtin_amdgcn_s_setprio(1); _Pragma("unroll") for (int m = 0; m < 4; ++m) _Pragma("unroll") for (int n = 0; n < 2; ++n) _Pragma("unroll") for (int k = 0; k < 2; ++k) \
        acc[ai][bj][m][n] = SWAP ? __builtin_amdgcn_mfma_f32_16x16x32_bf16(At[m][k], Bt[n][k], acc[ai][bj][m][n], 0, 0, 0) : __builtin_amdgcn_mfma_f32_16x16x32_bf16(Bt[n][k], At[m][k], acc[ai][bj][m][n], 0, 0, 0); __builtin_amdgcn_s_setprio(0); } while (0)
#define PG8_WAIT_V(n) asm volatile("s_waitcnt vmcnt(" #n ")" ::: "memory")
#define PG8_WAIT_L(n) asm volatile("s_waitcnt lgkmcnt(" #n ")" ::: "memory")
#define PG8_BAR __builtin_amdgcn_s_barrier()
#define PG8_SCHED __builtin_amdgcn_sched_barrier(0)
    Unit cur, nxt; int ui = 0;
    if (!S.next(0, cur)) return;
    f32x4 acc[2][2][4][2];
#pragma unroll
    for (int a = 0; a < 2; ++a)
#pragma unroll
        for (int b = 0; b < 2; ++b)
#pragma unroll
            for (int m = 0; m < 4; ++m)
#pragma unroll
                for (int n = 0; n < 2; ++n) acc[a][b][m][n] = (f32x4){0.f, 0.f, 0.f, 0.f};
    bf16x8 At[4][2], B0[2][2], B1[2][2];
    const char* cA = (const char*)g.A + (size_t)cur.pm * tstep; const char* cB = (const char*)g.Bt + (size_t)cur.pn * tstep;
    S.a_ready(cur);
    if constexpr (SP2) {
        PG8_STAGE(PG8_SB(0, 0), cB, voffB); PG8_STAGE(PG8_SB(0, 1), cB + hstep, voffB); PG8_STAGE(PG8_SA(0, 0), cA, voffA); PG8_STAGE(PG8_SA(0, 1), cA + hstep, voffA);
        if (wr == 1) PG8_BAR;
        PG8_WAIT_V(2); PG8_BAR;
        PG8_STAGE(PG8_SB(1, 0), cB + kstep, voffB); PG8_STAGE(PG8_SA(1, 0), cA + kstep, voffA); PG8_STAGE(PG8_SB(1, 1), cB + hstep + kstep, voffB);
        PG8_WAIT_V(6); PG8_BAR;
    } else {
        PG8_STAGE(PG8_SB(0, 0), cB, voffB); PG8_STAGE(PG8_SA(0, 0), cA, voffA); PG8_STAGE(PG8_SB(0, 1), cB + hstep, voffB); PG8_STAGE(PG8_SA(0, 1), cA + hstep, voffA);
        if (wr == 1) PG8_BAR;
        PG8_WAIT_V(4); PG8_BAR;
        PG8_STAGE(PG8_SB(1, 0), cB + kstep, voffB); PG8_STAGE(PG8_SA(1, 0), cA + kstep, voffA); PG8_STAGE(PG8_SB(1, 1), cB + hstep + kstep, voffB);
        PG8_WAIT_V(6); PG8_BAR;
    }
    for (;;) {
        const bool has_next = S.next(ui + 1, nxt);
        const char* nA = has_next ? (const char*)g.A + (size_t)nxt.pm * tstep : cA; const char* nB = has_next ? (const char*)g.Bt + (size_t)nxt.pn * tstep : cB;
        for (int t = 0; t < nt; t += 2) {
            const bool last = (t == nt - 2);
            const char* a1 = cA + (size_t)(t + 1) * kstep;
            const char* a2 = last ? nA : cA + (size_t)(t + 2) * kstep; const char* b2 = last ? nB : cB + (size_t)(t + 2) * kstep;
            const char* a3 = a2 + kstep; const char* b3 = b2 + kstep;
            if (last && has_next) S.a_ready(nxt);
            if constexpr (SP2) {
            PG8_LDB(B0, 0, 0); PG8_LDB(B1, 0, 1); PG8_SCHED; PG8_LDA(At, 0, 0); PG8_STAGE(PG8_SA(1, 1), a1 + hstep, voffA);
            PG8_WAIT_V(8); PG8_WAIT_L(0); PG8_BAR; PG8_MMA(0, 0, At, B0); PG8_MMA(0, 1, At, B1); PG8_BAR; PG8_SCHED;
            PG8_LDA(At, 0, 1); PG8_STAGE(PG8_SB(0, 0), b2, voffB); PG8_STAGE(PG8_SB(0, 1), b2 + hstep, voffB); PG8_STAGE(PG8_SA(0, 0), a2, voffA);
            PG8_WAIT_V(8); PG8_WAIT_L(0); PG8_BAR; PG8_MMA(1, 0, At, B0); PG8_MMA(1, 1, At, B1); PG8_BAR; PG8_SCHED;
            PG8_LDB(B0, 1, 0); PG8_LDB(B1, 1, 1); PG8_SCHED; PG8_LDA(At, 1, 0); PG8_STAGE(PG8_SA(0, 1), a2 + hstep, voffA);
            PG8_WAIT_V(8); PG8_WAIT_L(0); PG8_BAR; PG8_MMA(0, 0, At, B0); PG8_MMA(0, 1, At, B1); PG8_BAR; PG8_SCHED;
            PG8_LDA(At, 1, 1); PG8_STAGE(PG8_SB(1, 0), b3, voffB); PG8_STAGE(PG8_SB(1, 1), b3 + hstep, voffB); PG8_STAGE(PG8_SA(1, 0), a3, voffA);
            PG8_WAIT_V(8); PG8_WAIT_L(0); PG8_BAR; PG8_MMA(1, 0, At, B0); PG8_MMA(1, 1, At, B1); PG8_BAR; PG8_SCHED;
            } else {
            PG8_LDB(B0, 0, 0); PG8_SCHED; PG8_LDA(At, 0, 0); PG8_STAGE(PG8_SA(1, 1), a1 + hstep, voffA);
            PG8_WAIT_L(8); PG8_BAR; PG8_WAIT_L(0); PG8_MMA(0, 0, At, B0); PG8_BAR; PG8_SCHED;
            PG8_LDB(B1, 0, 1); PG8_STAGE(PG8_SB(0, 0), b2, voffB);
            PG8_BAR; PG8_WAIT_L(0); PG8_MMA(0, 1, At, B1); PG8_BAR;
            PG8_LDA(At, 0, 1); PG8_STAGE(PG8_SA(0, 0), a2, voffA);
            PG8_BAR; PG8_WAIT_L(0); PG8_MMA(1, 0, At, B0); PG8_BAR; PG8_SCHED;
            PG8_STAGE(PG8_SB(0, 1), b2 + hstep, voffB);
            PG8_WAIT_V(6); PG8_BAR; PG8_MMA(1, 1, At, B1); PG8_BAR;
            PG8_LDB(B0, 1, 0); PG8_SCHED; PG8_LDA(At, 1, 0); PG8_STAGE(PG8_SA(0, 1), a2 + hstep, voffA);
            PG8_WAIT_L(8); PG8_BAR; PG8_WAIT_L(0); PG8_MMA(0, 0, At, B0); PG8_BAR; PG8_SCHED;
            PG8_LDB(B1, 1, 1); PG8_STAGE(PG8_SB(1, 0), b3, voffB);
            PG8_BAR; PG8_WAIT_L(0); PG8_MMA(0, 1, At, B1); PG8_BAR;
            PG8_LDA(At, 1, 1); PG8_STAGE(PG8_SA(1, 0), a3, voffA);
            PG8_BAR; PG8_WAIT_L(0); PG8_MMA(1, 0, At, B0); PG8_BAR; PG8_SCHED;
            PG8_STAGE(PG8_SB(1, 1), b3 + hstep, voffB);
            PG8_WAIT_V(6); PG8_BAR; PG8_MMA(1, 1, At, B1); PG8_BAR;
            }
        }
        if constexpr (ALIGN_EPI) { if (wr == 0) PG8_BAR; }
        if constexpr (!Epi::AFTER_DRAIN) { E(acc, cur, wr, wc, fr, fq); S.done(cur); }
        if (!has_next) break;
#pragma unroll
        for (int a = 0; a < 2; ++a)
#pragma unroll
            for (int b = 0; b < 2; ++b)
#pragma unroll
                for (int m = 0; m < 4; ++m)
#pragma unroll
                    for (int n = 0; n < 2; ++n) acc[a][b][m][n] = (f32x4){0.f, 0.f, 0.f, 0.f};
        cur = nxt; cA = nA; cB = nB; ++ui;
        if constexpr (ALIGN_EPI) { if (wr == 1) PG8_BAR; }
    }
    PG8_WAIT_V(0);
    if constexpr (!ALIGN_EPI) { if (wr == 0) PG8_BAR; }
    PG8_BAR;
    if constexpr (Epi::AFTER_DRAIN) { E.fused(acc, cur, wr, wc, fr, fq, lds, wid, lane); S.done(cur); }
#undef PG8_SA
#undef PG8_SB
#undef PG8_STAGE
#undef PG8_LDA
#undef PG8_LDB
#undef PG8_MMA
#undef PG8_WAIT_V
#undef PG8_WAIT_L
#undef PG8_BAR
#undef PG8_SCHED
}
}
#define GAS __attribute__((address_space(1)))
#define LAS __attribute__((address_space(3)))
typedef unsigned short bf16;
typedef unsigned v4u __attribute__((ext_vector_type(4)));
typedef float f32x4 __attribute__((ext_vector_type(4)));
typedef short bf16x8 __attribute__((ext_vector_type(8)));
typedef GAS unsigned gu32;
typedef GAS unsigned long long gu64;
#define RLX_AGENT __ATOMIC_RELAXED, __HIP_MEMORY_SCOPE_AGENT
#define LDS_WAIT() asm volatile("s_waitcnt lgkmcnt(0)" ::: "memory")
#define VM_WAIT() asm volatile("s_waitcnt vmcnt(0)" ::: "memory")
__device__ __forceinline__ unsigned long long rt() { return __builtin_amdgcn_s_memrealtime(); }
__device__ __forceinline__ unsigned f2bf(float f) { unsigned u = __builtin_bit_cast(unsigned, f); return (u + 0x7fffu + ((u >> 16) & 1u)) >> 16; }
__device__ __forceinline__ unsigned pk2(float lo, float hi) { return f2bf(lo) | (f2bf(hi) << 16); }

#define XB_TMO      128
#define XB_XCNT(j)  (256  + 64 * (j))
#define XB_XSUB(j)  (1280 + 64 * (j))
#define XB_XGEN(j)  (2304 + 64 * (j))
#define XB_TOP      3328
#define XB_TOPGEN   3392
#define XCD_BAR_WORDS 3456
#define XB_SPIN_CAP (1u << 18)

__device__ __forceinline__ unsigned xb_ld(unsigned* p)              { return __hip_atomic_load(p, __ATOMIC_RELAXED, __HIP_MEMORY_SCOPE_AGENT); }
__device__ __forceinline__ unsigned xb_add(unsigned* p, unsigned v) { return __hip_atomic_fetch_add(p, v, __ATOMIC_RELAXED, __HIP_MEMORY_SCOPE_AGENT); }
__device__ __forceinline__ unsigned xb_xcc_id() { return (unsigned)__builtin_amdgcn_s_getreg((3 << 11) | 20) & 0xFu; }
#define XB_SPIN(cond, bar) do { unsigned _sp = 0; while (cond) { __builtin_amdgcn_s_sleep(1); \
    if ((++_sp & 255u) == 0u) { if (xb_ld(&(bar)[XB_TMO])) break; if (_sp > XB_SPIN_CAP) { atomicAdd(&(bar)[XB_TMO], 1u); break; } } } } while (0)

struct XcdBarrier {
    unsigned* bar; unsigned x;
    volatile LAS unsigned* st;
};

__device__ __forceinline__ XcdBarrier xcd_barrier_post(unsigned* bar, volatile LAS unsigned* st) {
    XcdBarrier b; b.bar = bar; b.x = xb_xcc_id(); b.st = st;
    if (threadIdx.x == 0) (void)xb_add(&bar[XB_XCNT(b.x)], 1u);
    return b;
}
__device__ __forceinline__ void xcd_barrier_complete(unsigned* bar, unsigned x, unsigned& nloc, unsigned& nx) {
    const unsigned G = gridDim.x * gridDim.y * gridDim.z;
    unsigned sum, cnt, mine, sp = 0u;
    for (;;) {
        sum = 0u; cnt = 0u; mine = 0u;
#pragma unroll
        for (unsigned j = 0; j < 16; ++j) { const unsigned c = xb_ld(&bar[XB_XCNT(j)]); sum += c; cnt += (c > 0u) ? 1u : 0u; mine = (j == x) ? c : mine; }
        if (sum == G) break;
        __builtin_amdgcn_s_sleep(1);
        if ((++sp & 255u) == 0u) { if (xb_ld(&bar[XB_TMO])) break; if (sp > XB_SPIN_CAP) { atomicAdd(&bar[XB_TMO], 1u); break; } }
    }
    nloc = mine > 0u ? mine : 1u; nx = cnt > 0u ? cnt : 1u;
}

__device__ __forceinline__ void xcd_barrier(const XcdBarrier& b) {
    asm volatile("s_waitcnt vmcnt(0)" ::: "memory");
    __syncthreads();
    if (threadIdx.x == 0) {
        unsigned* bar = b.bar;
        __builtin_amdgcn_s_waitcnt(0);
        unsigned nloc = b.st[0], nx = b.st[1];
        if (nloc == 0u) { xcd_barrier_complete(bar, b.x, nloc, nx); b.st[0] = nloc; b.st[1] = nx; }
        const unsigned old = xb_add(&bar[XB_XSUB(b.x)], 1u);
        const unsigned gen = old / nloc;
        if (old + 1u == (gen + 1u) * nloc) {
            __builtin_amdgcn_fence(__ATOMIC_RELEASE, "agent");
            asm volatile("s_waitcnt vmcnt(0)" ::: "memory");
            const unsigned og = xb_add(&bar[XB_TOP], 1u);
            const unsigned tg = og / nx;
            if (og + 1u == (tg + 1u) * nx) xb_add(&bar[XB_TOPGEN], 1u);
            else XB_SPIN(xb_ld(&bar[XB_TOPGEN]) == tg, bar);
            __builtin_amdgcn_fence(__ATOMIC_ACQUIRE, "agent");
            xb_add(&bar[XB_XGEN(b.x)], 1u);
            asm volatile("s_waitcnt vmcnt(0)" ::: "memory");
        } else {
            XB_SPIN(xb_ld(&bar[XB_XGEN(b.x)]) == gen, bar);
            __builtin_amdgcn_fence(__ATOMIC_ACQUIRE, "agent");
            asm volatile("s_waitcnt vmcnt(0)" ::: "memory");
        }
    }
    __syncthreads();
}

constexpr int DM = 2048, NB = 2, SEQ = 8192, CTX = 256, DEPTH = 4;
constexpr int NLAT = NB * SEQ, NCTXR = NB * CTX, MALL = NLAT + NCTXR;
constexpr int INC = 4352, PP = 2816, HYC = 1536;
constexpr int FH = 5632, F2 = 11264;
constexpr int OFF_QA = 0, OFF_KA = 512, OFF_VA = 1024, OFF_QB = 1536, OFF_KB = 2048, OFF_VB = 2176, OFF_POOL = 2304;
constexpr int NFFT = 16384;
constexpr float QSCALE = 0.125f * 1.4426950408889634f;
constexpr float RMS_EPS = 1e-6f;
constexpr int MODKS = 8;

constexpr size_t MiB = 1u << 20;
constexpr size_t WS_CTL = 0, CTL_ZERO_BYTES = 2 * MiB;
constexpr size_t WS_MOD = 2 * MiB;
constexpr size_t WS_ROPE = 3 * MiB;
constexpr size_t WS_LAMB = 3 * MiB + 65536;
constexpr size_t WS_MODP = 4 * MiB;
constexpr size_t WS_KC = 9 * MiB;
constexpr size_t WS_CTXW = 13 * MiB;
constexpr size_t WS_HID = 17 * MiB;
constexpr size_t WS_HIDC = 25 * MiB;
constexpr size_t WS_WIN = 26 * MiB;
constexpr size_t WS_WOUT = 94 * MiB;
constexpr size_t WS_WF1 = 126 * MiB;
constexpr size_t WS_WF2 = 302 * MiB;
constexpr size_t WS_KF = 390 * MiB;
constexpr size_t WS_H = 646 * MiB;
constexpr size_t WS_A = 712 * MiB;
constexpr size_t WS_U = 894 * MiB;
constexpr size_t WS_P = 894 * MiB;
constexpr size_t WS_PT = 985 * MiB;
constexpr size_t WS_MIX = 1035 * MiB;
constexpr size_t WS_ASCR = 1101 * MiB;
constexpr size_t WS_KRAW = 894 * MiB;
constexpr size_t WS_KCRAW = 1030 * MiB;
constexpr size_t WS_END = 1257 * MiB;
static_assert(WS_MOD + 4 * 3 * 12288 * 4 <= WS_ROPE && WS_MODP + (size_t)MODKS * 4 * 3 * 12288 * 4 <= WS_KC && WS_KC + 4u * 512 * 512 * 4 <= WS_CTXW, "ws map 1");
static_assert(WS_WIN + (size_t)4 * INC * DM * 2 <= WS_WOUT && WS_WF1 + (size_t)4 * F2 * DM * 2 <= WS_WF2 && WS_WF2 + (size_t)4 * DM * FH * 2 <= WS_KF, "ws map 2");
static_assert(WS_KF + (size_t)4 * 512 * NFFT * 8 <= WS_H && WS_H + (size_t)MALL * DM * 2 <= WS_A && WS_A + (size_t)MALL * FH * 2 <= WS_U && WS_U + (size_t)MALL * F2 * 2 <= WS_END, "ws map 3");
static_assert(WS_P + (size_t)MALL * PP * 2 <= WS_PT && WS_PT + (size_t)HYC * MALL * 2 <= WS_MIX && WS_MIX + (size_t)MALL * DM * 2 <= WS_ASCR && WS_ASCR + 32 * MiB <= WS_END, "ws map 4");
static_assert(WS_KRAW + (size_t)4 * 512 * NFFT * 4 <= WS_KCRAW && WS_KCRAW + 4 * MiB <= WS_END, "ws map 5");
constexpr int CW_BAR = 4096;

constexpr int RING_BYTES = 131072;
constexpr int SCR_OFF = RING_BYTES;
constexpr int WSF_OFF = RING_BYTES + 1024;
constexpr int MISC_OFF = RING_BYTES + 4096;
constexpr int LDS_BYTES = 147456;
constexpr int NWAVES = 8;

typedef float f32x2 __attribute__((ext_vector_type(2)));
typedef unsigned u32x2 __attribute__((ext_vector_type(2)));
__device__ __forceinline__ float bf2f(unsigned short h) { return __builtin_bit_cast(float, (unsigned)h << 16); }
__device__ __forceinline__ float bflo(unsigned w) { return __builtin_bit_cast(float, w << 16); }
__device__ __forceinline__ float bfhi(unsigned w) { return __builtin_bit_cast(float, w & 0xffff0000u); }
__device__ __forceinline__ float wave_sum(float v) {
#pragma unroll
    for (int o = 1; o < 64; o <<= 1) v += __shfl_xor(v, o);
    return v;
}
__host__ __device__ __forceinline__ void sincos_acc(double x, float& s, float& c) {
    const double k = __builtin_rint(x * 0.63661977236758134308);
    const double r = x - k * 1.57079632679489661923;
    const int q = ((int)k) & 3;
    const double r2 = r * r;
    const double sp = r * (1.0 + r2 * (-1.0 / 6 + r2 * (1.0 / 120 + r2 * (-1.0 / 5040 + r2 * (1.0 / 362880 + r2 * (-1.0 / 39916800 + r2 * (1.0 / 6227020800.0)))))));
    const double cp = 1.0 + r2 * (-0.5 + r2 * (1.0 / 24 + r2 * (-1.0 / 720 + r2 * (1.0 / 40320 + r2 * (-1.0 / 3628800 + r2 * (1.0 / 479001600.0))))));
    const double ss = (q == 0) ? sp : (q == 1) ? cp : (q == 2) ? -sp : -cp;
    const double cc = (q == 0) ? cp : (q == 1) ? -sp : (q == 2) ? -cp : sp;
    s = (float)ss; c = (float)cc;
}
__host__ __device__ __forceinline__ void tw_cs(int m, float& c, float& s) {
    const int oct = m >> 11, r = m & 2047;
    const int rr = (oct & 1) ? 2048 - r : r;
    const float a = (float)rr * 3.834951969714103e-4f;
    const float a2 = a * a;
    const float sp = a * (1.f + a2 * (-1.f / 6 + a2 * (1.f / 120 + a2 * (-1.f / 5040 + a2 * (1.f / 362880)))));
    const float cp = 1.f + a2 * (-0.5f + a2 * (1.f / 24 + a2 * (-1.f / 720 + a2 * (1.f / 40320 + a2 * (-1.f / 3628800)))));
    float cc, ss;
    switch (oct) {
        case 0: cc = cp; ss = sp; break;
        case 1: cc = sp; ss = cp; break;
        case 2: cc = -sp; ss = cp; break;
        case 3: cc = -cp; ss = sp; break;
        case 4: cc = -cp; ss = -sp; break;
        case 5: cc = -sp; ss = -cp; break;
        case 6: cc = sp; ss = -cp; break;
        default: cc = cp; ss = -sp; break;
    }
    c = cc; s = ss;
}

template <int THREADS>
__host__ __device__ __forceinline__ void fft_stage_fwd(f32x2* X, int s, int tid) {
    const int lq = 12 - 2 * s, q = 1 << lq;
    for (int b = tid; b < 4096; b += THREADS) {
        const int j = b & (q - 1), grp = b >> lq, base = (grp << (lq + 2)) + j;
        const f32x2 a0 = X[base], a1 = X[base + q], a2 = X[base + 2 * q], a3 = X[base + 3 * q];
        const f32x2 t0 = a0 + a2, t1 = a0 - a2, t2 = a1 + a3;
        const f32x2 d13 = a1 - a3; const f32x2 t3 = {d13.y, -d13.x};
        const f32x2 y0 = t0 + t2, u1 = t1 + t3, u2 = t0 - t2, u3 = t1 - t3;
        float c1, s1; tw_cs((j << (2 * s)) & (NFFT - 1), c1, s1);
        const float c2 = c1 * c1 - s1 * s1, s2 = 2.f * c1 * s1;
        const float c3 = c2 * c1 - s2 * s1, s3 = s2 * c1 + c2 * s1;
        X[base] = y0;
        X[base + q] = (f32x2){u1.x * c1 + u1.y * s1, u1.y * c1 - u1.x * s1};
        X[base + 2 * q] = (f32x2){u2.x * c2 + u2.y * s2, u2.y * c2 - u2.x * s2};
        X[base + 3 * q] = (f32x2){u3.x * c3 + u3.y * s3, u3.y * c3 - u3.x * s3};
    }
}
template <int THREADS>
__host__ __device__ __forceinline__ void fft_stage_inv(f32x2* X, int s, int tid) {
    const int lq = 12 - 2 * s, q = 1 << lq;
    for (int b = tid; b < 4096; b += THREADS) {
        const int j = b & (q - 1), grp = b >> lq, base = (grp << (lq + 2)) + j;
        const f32x2 b0 = X[base], b1 = X[base + q], b2 = X[base + 2 * q], b3 = X[base + 3 * q];
        float c1, s1; tw_cs((j << (2 * s)) & (NFFT - 1), c1, s1);
        const float c2 = c1 * c1 - s1 * s1, s2 = 2.f * c1 * s1;
        const float c3 = c2 * c1 - s2 * s1, s3 = s2 * c1 + c2 * s1;
        const f32x2 e1 = {b1.x * c1 - b1.y * s1, b1.y * c1 + b1.x * s1};
        const f32x2 e2 = {b2.x * c2 - b2.y * s2, b2.y * c2 + b2.x * s2};
        const f32x2 e3 = {b3.x * c3 - b3.y * s3, b3.y * c3 + b3.x * s3};
        const f32x2 t0 = b0 + e2, t1 = b0 - e2, t2 = e1 + e3;
        const f32x2 d13 = e1 - e3; const f32x2 t3 = {-d13.y, d13.x};
        X[base] = t0 + t2;
        X[base + q] = t1 + t3;
        X[base + 2 * q] = t0 - t2;
        X[base + 3 * q] = t1 - t3;
    }
}

struct Args { const float* in[29]; float* out; unsigned char* ws; };
enum InIdx { I_X = 0, I_C, I_CTX, I_CCTX, I_WMOD, I_BMOD, I_N1G, I_N2G, I_WIN, I_WOUT, I_QKG, I_LAM, I_SUBLN, I_SINK, I_POOLW, I_POOLS, I_HCW, I_HCB, I_HW1, I_HB1, I_HW2, I_HB2, I_HW3, I_HFREQ, I_HBIAS, I_FW1, I_FCW, I_FCB, I_FW2 };
struct Frame {
    LAS unsigned char* lds; char* ldsg;
    volatile LAS unsigned* MISC;
    gu32* ctl;
    int tid, lane, wave, vcu, G, gw, NGW;
    const Args __attribute__((address_space(4)))* a;
};
#define WSP(T, off) ((T*)(F.a->ws + (off)))

__device__ __forceinline__ void p0_transpose_item(const float* W, int K, int N, bf16* WT, bool perm, LAS float* scr, int item, int lane) {
    const int nblk = N / 32, kb = item / nblk, nb = item % nblk, k0 = 64 * kb, n0 = 32 * nb;
#pragma unroll 8
    for (int i = 0; i < 32; ++i) { const int kk = 2 * i + (lane >> 5); scr[kk * 33 + (lane & 31)] = W[(size_t)(k0 + kk) * N + n0 + (lane & 31)]; }
    LDS_WAIT(); asm volatile("" ::: "memory");
    int orow0 = n0;
    if (perm) { const int tile = n0 >> 8, gl = (n0 >> 5) & 7, wc = gl >> 1, bj = gl & 1; orow0 = tile * 256 + (4 * bj + wc) * 32; }
    const int c = lane & 7;
#pragma unroll
    for (int j = 0; j < 4; ++j) { const int n = (lane >> 3) + 8 * j; const LAS float* s = scr + (8 * c) * 33 + n;
        v4u o; o.x = pk2(s[0 * 33], s[1 * 33]); o.y = pk2(s[2 * 33], s[3 * 33]); o.z = pk2(s[4 * 33], s[5 * 33]); o.w = pk2(s[6 * 33], s[7 * 33]);
        *(GAS v4u*)(WT + (size_t)(orow0 + n) * K + k0 + 8 * c) = o; }
    LDS_WAIT(); asm volatile("" ::: "memory");
}

__device__ __forceinline__ float silu_f(float v) { return v / (1.f + __expf(-v)); }

__device__ __forceinline__ void prologue_a(Frame& F) {
    LAS float* scr = (LAS float*)(F.lds + F.wave * 16384);
    const int gw = F.gw, NGW = F.NGW, lane = F.lane;
    constexpr int IT_WIN = (DM / 64) * (INC / 32), IT_WOUT = (DM / 64) * (DM / 32), IT_F1 = (DM / 64) * (F2 / 32), IT_F2 = (FH / 64) * (DM / 32), IT_L = IT_WIN + IT_WOUT + IT_F1 + IT_F2;
    for (int it = gw; it < DEPTH * IT_L; it += NGW) {
        const int l = it / IT_L; int r = it % IT_L;
        if (r < IT_WIN) { p0_transpose_item(F.a->in[I_WIN] + (size_t)l * DM * INC, DM, INC, WSP(bf16, WS_WIN) + (size_t)l * INC * DM, true, scr, r, lane); continue; } r -= IT_WIN;
        if (r < IT_WOUT) { p0_transpose_item(F.a->in[I_WOUT] + (size_t)l * DM * DM, DM, DM, WSP(bf16, WS_WOUT) + (size_t)l * DM * DM, false, scr, r, lane); continue; } r -= IT_WOUT;
        if (r < IT_F1) { p0_transpose_item(F.a->in[I_FW1] + (size_t)l * DM * F2, DM, F2, WSP(bf16, WS_WF1) + (size_t)l * F2 * DM, false, scr, r, lane); continue; } r -= IT_F1;
        p0_transpose_item(F.a->in[I_FW2] + (size_t)l * FH * DM, FH, DM, WSP(bf16, WS_WF2) + (size_t)l * DM * FH, false, scr, r, lane);
    }
    {
        const float* cvec = F.a->in[I_C]; const float* cctx = F.a->in[I_CCTX]; const float* wmod = F.a->in[I_WMOD]; float* modp = WSP(float, WS_MODP);
        for (int it = gw; it < DEPTH * 192 * MODKS; it += NGW) {
            const int ks = it % MODKS, cc = (it / MODKS) % 192, l = it / (MODKS * 192), k0 = ks * 256, col = cc * 64 + lane;
#pragma unroll
            for (int i = 0; i < 4; ++i) { const int k = lane + 64 * i;
                scr[k] = silu_f(cvec[k0 + k]); scr[256 + k] = silu_f(cvec[DM + k0 + k]); scr[512 + k] = silu_f(cctx[k0 + k]); }
            LDS_WAIT(); asm volatile("" ::: "memory");
            float a0 = 0.f, a1 = 0.f, a2 = 0.f; const float* wp = wmod + ((size_t)l * DM + k0) * 12288 + col;
#pragma unroll 8
            for (int k = 0; k < 256; ++k) { const float w = wp[(size_t)k * 12288]; a0 += scr[k] * w; a1 += scr[256 + k] * w; a2 += scr[512 + k] * w; }
            float* mp = modp + ((size_t)(ks * DEPTH + l) * 3) * 12288 + col; mp[0] = a0; mp[12288] = a1; mp[2 * 12288] = a2;
            LDS_WAIT(); asm volatile("" ::: "memory");
        }
    }
    {
        for (int it = gw; it < 2048 + 64; it += NGW) {
            int l, t0, Ls; float* dst;
            if (it < 2048) { l = it >> 9; t0 = (it & 511) * 16; Ls = SEQ; dst = WSP(float, WS_HID) + ((size_t)l * SEQ + t0) * 64; }
            else { const int j = it - 2048; l = j >> 4; t0 = (j & 15) * 16; Ls = CTX; dst = WSP(float, WS_HIDC) + ((size_t)l * CTX + t0) * 64; }
            const float* w1 = F.a->in[I_HW1] + l * 33 * 64; const float* w2 = F.a->in[I_HW2] + l * 64 * 64;
            const float b1 = F.a->in[I_HB1][l * 64 + lane], b2 = F.a->in[I_HB2][l * 64 + lane], fr = F.a->in[I_HFREQ][l * 64 + lane];
            for (int p = 0; p < 16; ++p) {
                const int t = t0 + p;
                float z = 0.f;
                if (lane == 0) z = (float)t / (float)(Ls - 1);
                else if (lane <= 32) { const int e = (lane - 1) & 15; const float f = 1e-4f + (float)e * ((15.f - 1e-4f) / 15.f); const float wang = 6.283185307179586f * (float)t / (float)Ls;
                    float s, c; sincos_acc((double)(f * wang), s, c); z = (lane <= 16) ? c : -s; }
                float acc = 0.f;
#pragma unroll
                for (int e = 0; e < 33; ++e) acc += __builtin_bit_cast(float, __builtin_amdgcn_readlane(__builtin_bit_cast(int, z), e)) * w1[e * 64 + lane];
                float s1, c1; sincos_acc((double)(fr * (acc + b1)), s1, c1);
                float acc2 = 0.f;
#pragma unroll
                for (int i = 0; i < 64; ++i) acc2 += __builtin_bit_cast(float, __builtin_amdgcn_readlane(__builtin_bit_cast(int, s1), i)) * w2[i * 64 + lane];
                float s2, c2; sincos_acc((double)(fr * (acc2 + b2)), s2, c2);
                dst[p * 64 + lane] = s2;
            }
        }
    }
    for (int e = gw * 64 + lane; e < 128 * 16; e += NGW * 64) { const int pos = e >> 4, f = e & 15;
        double invd = 1.0; for (int q = 0; q < f; ++q) invd *= 0.56234132519034908;     const float inv = (float)invd;
        const float ang = (float)pos * inv; float s, c; sincos_acc((double)ang, s, c);
        WSP(float, WS_ROPE)[2 * e] = c; WSP(float, WS_ROPE)[2 * e + 1] = s; }
    if (gw < DEPTH) { const int l = gw; const float* lp = F.a->in[I_LAM] + l * 256;
        const float s1 = wave_sum(lp[lane] * lp[64 + lane]), s2 = wave_sum(lp[128 + lane] * lp[192 + lane]);
        const float linit = 0.8f - 0.6f * __expf(-0.3f * (float)l);
        if (lane == 0) WSP(float, WS_LAMB)[l] = __expf(s1) - __expf(s2) + linit; }
    { const GAS f32x4* xs = (const GAS f32x4*)F.a->in[I_X]; GAS f32x4* xd = (GAS f32x4*)F.a->out;
      for (size_t i = (size_t)gw * 64 + lane; i < (size_t)NLAT * DM / 4; i += (size_t)NGW * 64) xd[i] = xs[i];
      const GAS f32x4* cs = (const GAS f32x4*)F.a->in[I_CTX]; GAS f32x4* cd = (GAS f32x4*)WSP(float, WS_CTXW);
      for (size_t i = (size_t)gw * 64 + lane; i < (size_t)NCTXR * DM / 4; i += (size_t)NGW * 64) cd[i] = cs[i]; }
}

__device__ __forceinline__ void prologue_b(Frame& F) {
    { const float* modp = WSP(float, WS_MODP); float* mod = WSP(float, WS_MOD); const float* bm = F.a->in[I_BMOD];
      for (int e = F.gw * 64 + F.lane; e < DEPTH * 3 * 12288; e += F.NGW * 64) { const int col = e % 12288, l = e / (3 * 12288);
          float a = bm[l * 12288 + col];
#pragma unroll
          for (int ks = 0; ks < MODKS; ++ks) a += modp[(size_t)ks * DEPTH * 3 * 12288 + e];
          mod[e] = a; } }
    LAS float* hs = (LAS float*)F.lds; LAS float* wsm = hs + 64 * 65;
    const int tl = F.tid & 63, cy = F.tid >> 6;
    const int NIT_L = DEPTH * 128 * 16, NIT_C = DEPTH * 4 * 16;
    for (int it = blockIdx.x; it < NIT_L + NIT_C; it += F.G) {
        int l, t0, c0, Ls; const float* hid; float* dstbase;
        if (it < NIT_L) { l = it / (128 * 16); const int r = it % (128 * 16); t0 = (r / 16) * 64; c0 = (r % 16) * 64; Ls = SEQ; hid = WSP(float, WS_HID) + ((size_t)l * SEQ + t0) * 64; dstbase = WSP(float, WS_KRAW) + (size_t)l * 512 * NFFT; }
        else { const int j = it - NIT_L; l = j / 64; const int r = j % 64; t0 = (r / 16) * 64; c0 = (r % 16) * 64; Ls = CTX; hid = WSP(float, WS_HIDC) + ((size_t)l * CTX + t0) * 64; dstbase = WSP(float, WS_KCRAW) + (size_t)l * 512 * 512; }
        const float* w3 = F.a->in[I_HW3] + (size_t)l * 64 * 1024 + c0;
#pragma unroll
        for (int k = 0; k < 8; ++k) { const int idx = F.tid + 512 * k, r = idx >> 6, i = idx & 63; hs[r * 65 + i] = hid[idx]; wsm[idx] = w3[(size_t)r * 1024 + i]; }
        __syncthreads();
        float acc[8];
#pragma unroll
        for (int e = 0; e < 8; ++e) acc[e] = 0.f;
#pragma unroll 4
        for (int i = 0; i < 64; ++i) { const float hv = hs[tl * 65 + i]; const f32x4 wa = *(const LAS f32x4*)(wsm + i * 64 + cy * 8), wb = *(const LAS f32x4*)(wsm + i * 64 + cy * 8 + 4);
            acc[0] += hv * wa.x; acc[1] += hv * wa.y; acc[2] += hv * wa.z; acc[3] += hv * wa.w; acc[4] += hv * wb.x; acc[5] += hv * wb.y; acc[6] += hv * wb.z; acc[7] += hv * wb.w; }
        const int t = t0 + tl; const float t01 = (float)t / (float)(Ls - 1);
#pragma unroll
        for (int e = 0; e < 8; ++e) { const int c = c0 + cy * 8 + e, dir = c >> 9, chn = c & 511;
            const float delta = -15.350567286626973f + (-3.0701134573253946f + 15.350567286626973f) * ((float)chn / 511.f);
            float val = acc[e] * __expf(t01 * delta);
            int pos = t; if (dir) { pos = (t == 0) ? Ls : 2 * Ls - t; if (t == 0) val = 0.f; }
            dstbase[(size_t)chn * (2 * Ls) + pos] = val; }
        __syncthreads();
    }
}

__device__ __forceinline__ void prologue_c(Frame& F) {
    f32x2* X = (f32x2*)F.ldsg; float* red = (float*)(F.ldsg + SCR_OFF);
    for (int it = blockIdx.x; it < DEPTH * 512; it += F.G) {
        const float* kr = WSP(float, WS_KRAW) + (size_t)it * NFFT; float v[32]; float ss = 0.f;
#pragma unroll
        for (int k = 0; k < 32; ++k) { v[k] = kr[F.tid + 512 * k]; ss += v[k] * v[k]; }
        ss = wave_sum(ss); if (F.lane == 0) red[F.wave] = ss;
        __syncthreads();
        float tot = 0.f;
#pragma unroll
        for (int w = 0; w < 8; ++w) tot += red[w];
        const float sc = (1.0f / sqrtf(tot + RMS_EPS)) * (1.0f / (float)NFFT);
#pragma unroll
        for (int k = 0; k < 32; ++k) X[F.tid + 512 * k] = (f32x2){v[k] * sc, 0.f};
        __syncthreads();
#pragma unroll 1
        for (int s = 0; s < 7; ++s) { fft_stage_fwd<512>(X, s, F.tid); __syncthreads(); }
        f32x2* kf = WSP(f32x2, WS_KF) + (size_t)it * NFFT;
#pragma unroll
        for (int k = 0; k < 32; ++k) kf[F.tid + 512 * k] = X[F.tid + 512 * k];
        __syncthreads();
    }
    for (int it = F.gw; it < DEPTH * 512; it += F.NGW) {
        const float* kr = WSP(float, WS_KCRAW) + (size_t)it * 512; float v[8]; float ss = 0.f;
#pragma unroll
        for (int k = 0; k < 8; ++k) { v[k] = kr[F.lane + 64 * k]; ss += v[k] * v[k]; }
        const float sc = 1.0f / sqrtf(wave_sum(ss) + RMS_EPS);
        float* kc = WSP(float, WS_KC) + (size_t)it * 512;
#pragma unroll
        for (int k = 0; k < 8; ++k) kc[F.lane + 64 * k] = v[k] * sc;
    }
}

__device__ __forceinline__ void norm_phase(Frame& F, int l, int which, int nrows) {
    const float* g = (which ? F.a->in[I_N2G] : F.a->in[I_N1G]) + l * DM; const float* mod = WSP(float, WS_MOD) + (size_t)l * 3 * 12288;
    const int shoff = which ? 3 * DM : 0, scoff = which ? 4 * DM : DM;
    bf16* H = WSP(bf16, WS_H);
    for (int row = F.gw; row < nrows; row += F.NGW) {
        const int r = row < SEQ ? 0 : row < NLAT ? 1 : 2;
        const float* src = row < NLAT ? F.a->out + (size_t)row * DM : WSP(float, WS_CTXW) + (size_t)(row - NLAT) * DM;
        const GAS f32x4* xr = (const GAS f32x4*)src + F.lane; f32x4 v[8]; float ss = 0.f;
#pragma unroll
        for (int j = 0; j < 8; ++j) { v[j] = xr[64 * j]; ss += (v[j].x * v[j].x + v[j].y * v[j].y) + (v[j].z * v[j].z + v[j].w * v[j].w); }
        const float rstd = 1.0f / sqrtf(wave_sum(ss) * (1.f / DM) + RMS_EPS);
        GAS u32x2* o8 = (GAS u32x2*)(H + (size_t)row * DM) + F.lane;
#pragma unroll
        for (int j = 0; j < 8; ++j) { const int col = 4 * F.lane + 256 * j;
            const f32x4 gg = *(const f32x4*)(g + col), sc = *(const f32x4*)(mod + r * 12288 + scoff + col), sh = *(const f32x4*)(mod + r * 12288 + shoff + col);
            const f32x4 y = v[j] * rstd * gg * (sc + 1.f) + sh;
            u32x2 w; w.x = pk2(y.x, y.y); w.y = pk2(y.z, y.w); o8[64 * j] = w; }
    }
}

__device__ __forceinline__ void convact_phase(Frame& F, int l, int nrows) {
    const bf16* U = WSP(bf16, WS_U); bf16* A = WSP(bf16, WS_A);
    const float* cw = F.a->in[I_FCW] + (size_t)l * 3 * F2; const float* cb = F.a->in[I_FCB] + (size_t)l * F2;
    const int nrc = nrows / 16;
    for (int it = F.gw; it < nrc * 11; it += F.NGW) {
        const int rc = it / 11, cbk = it % 11, row0 = rc * 16, col = cbk * 512 + F.lane * 8;
        const int seqlen = row0 < NLAT ? SEQ : CTX, tloc = row0 < NLAT ? (row0 & (SEQ - 1)) : ((row0 - NLAT) & (CTX - 1));
        const bool has_prev = tloc > 0, has_next = tloc + 16 < seqlen;
        float wg[3][8], wu[3][8], bg[8], bu[8];
#pragma unroll
        for (int k = 0; k < 3; ++k) { const f32x4 a = *(const f32x4*)(cw + k * F2 + col), b = *(const f32x4*)(cw + k * F2 + col + 4), c = *(const f32x4*)(cw + k * F2 + FH + col), d = *(const f32x4*)(cw + k * F2 + FH + col + 4);
            wg[k][0] = a.x; wg[k][1] = a.y; wg[k][2] = a.z; wg[k][3] = a.w; wg[k][4] = b.x; wg[k][5] = b.y; wg[k][6] = b.z; wg[k][7] = b.w;
            wu[k][0] = c.x; wu[k][1] = c.y; wu[k][2] = c.z; wu[k][3] = c.w; wu[k][4] = d.x; wu[k][5] = d.y; wu[k][6] = d.z; wu[k][7] = d.w; }
        { const f32x4 a = *(const f32x4*)(cb + col), b = *(const f32x4*)(cb + col + 4), c = *(const f32x4*)(cb + FH + col), d = *(const f32x4*)(cb + FH + col + 4);
            bg[0] = a.x; bg[1] = a.y; bg[2] = a.z; bg[3] = a.w; bg[4] = b.x; bg[5] = b.y; bg[6] = b.z; bg[7] = b.w; bu[0] = c.x; bu[1] = c.y; bu[2] = c.z; bu[3] = c.w; bu[4] = d.x; bu[5] = d.y; bu[6] = d.z; bu[7] = d.w; }
        const v4u zero4 = {0u, 0u, 0u, 0u};
        v4u gp = has_prev ? *(const GAS v4u*)(U + (size_t)(row0 - 1) * F2 + col) : zero4, up = has_prev ? *(const GAS v4u*)(U + (size_t)(row0 - 1) * F2 + FH + col) : zero4;
        v4u gc = *(const GAS v4u*)(U + (size_t)row0 * F2 + col), uc = *(const GAS v4u*)(U + (size_t)row0 * F2 + FH + col);
#pragma unroll 4
        for (int i = 0; i < 16; ++i) {
            const bool nx = (i < 15) || has_next;
            const v4u gn = nx ? *(const GAS v4u*)(U + (size_t)(row0 + i + 1) * F2 + col) : zero4, un = nx ? *(const GAS v4u*)(U + (size_t)(row0 + i + 1) * F2 + FH + col) : zero4;
            unsigned ow[4];
#pragma unroll
            for (int w = 0; w < 4; ++w) {
                const float g0 = wg[0][2 * w] * bflo(gp[w]) + wg[1][2 * w] * bflo(gc[w]) + wg[2][2 * w] * bflo(gn[w]) + bg[2 * w];
                const float g1 = wg[0][2 * w + 1] * bfhi(gp[w]) + wg[1][2 * w + 1] * bfhi(gc[w]) + wg[2][2 * w + 1] * bfhi(gn[w]) + bg[2 * w + 1];
                const float u0 = wu[0][2 * w] * bflo(up[w]) + wu[1][2 * w] * bflo(uc[w]) + wu[2][2 * w] * bflo(un[w]) + bu[2 * w];
                const float u1 = wu[0][2 * w + 1] * bfhi(up[w]) + wu[1][2 * w + 1] * bfhi(uc[w]) + wu[2][2 * w + 1] * bfhi(un[w]) + bu[2 * w + 1];
                ow[w] = pk2(silu_f(g0) * u0, silu_f(g1) * u1); }
            *(GAS v4u*)(A + (size_t)(row0 + i) * FH + col) = (v4u){ow[0], ow[1], ow[2], ow[3]};
            gp = gc; gc = gn; up = uc; uc = un;
        }
    }
}

struct EpiInProj {
    static constexpr bool PERM = false, AFTER_DRAIN = false;
    bf16* P; const float* gain; const float* rope;
    __device__ __forceinline__ void operator()(const pg8::f32x4 (&acc)[2][2][4][2], const pg8::Unit& u, int wr, int wc, int fr, int fq) const {
        const int pn = u.pn;
        int gidx = -1; float scale = 1.f;
        if (pn < 2) { gidx = 0; scale = QSCALE; } else if (pn < 4) { gidx = 1; } else if (pn < 6) { gidx = -1; } else if (pn < 8) { gidx = 2; scale = QSCALE; } else if (pn == 8) { gidx = (wc < 2) ? 3 : -1; }
        const int colbase = pn * 256 + wc * 64 + 4 * fq;
        const bool lat = u.pm < 64;
        if (gidx >= 0) {
            pg8::f32x4 g[2][2];
#pragma unroll
            for (int bj = 0; bj < 2; ++bj)
#pragma unroll
                for (int n = 0; n < 2; ++n) g[bj][n] = *(const pg8::f32x4*)(gain + gidx * 64 + 32 * bj + 16 * n + 4 * fq) * scale;
#pragma unroll
            for (int ai = 0; ai < 2; ++ai)
#pragma unroll
                for (int m = 0; m < 4; ++m) {
                    const int row = u.pm * 256 + ai * 128 + wr * 64 + m * 16 + fr;
                    float ss = 0.f;
#pragma unroll
                    for (int bj = 0; bj < 2; ++bj)
#pragma unroll
                        for (int n = 0; n < 2; ++n) { const pg8::f32x4 x = acc[ai][bj][m][n]; ss += (x[0] * x[0] + x[1] * x[1]) + (x[2] * x[2] + x[3] * x[3]); }
                    ss += __shfl_xor(ss, 16); ss += __shfl_xor(ss, 32);
                    const float rstd = 1.0f / sqrtf(ss * (1.f / 64.f) + RMS_EPS);
                    const int t = row & (SEQ - 1);
#pragma unroll
                    for (int bj = 0; bj < 2; ++bj) {
                        pg8::f32x4 x1 = acc[ai][bj][m][0] * rstd * g[bj][0], x2 = acc[ai][bj][m][1] * rstd * g[bj][1];
                        if (lat) { const int pos = bj ? (t & 63) : (t >> 6); const float* rp = rope + (pos * 16 + 4 * fq) * 2;
                            const pg8::f32x4 ra = *(const pg8::f32x4*)rp, rb = *(const pg8::f32x4*)(rp + 4);
                            const pg8::f32x4 c = {ra[0], ra[2], rb[0], rb[2]}, s = {ra[1], ra[3], rb[1], rb[3]};
                            const pg8::f32x4 o1 = x1 * c - x2 * s, o2 = x2 * c + x1 * s; x1 = o1; x2 = o2; }
                        bf16* dst = P + (size_t)row * PP + colbase + 32 * bj;
                        u32x2 w1; w1.x = pk2(x1[0], x1[1]); w1.y = pk2(x1[2], x1[3]); *(u32x2*)dst = w1;
                        u32x2 w2; w2.x = pk2(x2[0], x2[1]); w2.y = pk2(x2[2], x2[3]); *(u32x2*)(dst + 16) = w2;
                    }
                }
        } else {
#pragma unroll
            for (int ai = 0; ai < 2; ++ai)
#pragma unroll
                for (int m = 0; m < 4; ++m) {
                    const int row = u.pm * 256 + ai * 128 + wr * 64 + m * 16 + fr;
#pragma unroll
                    for (int bj = 0; bj < 2; ++bj)
#pragma unroll
                        for (int n = 0; n < 2; ++n) { const pg8::f32x4 x = acc[ai][bj][m][n]; u32x2 w; w.x = pk2(x[0], x[1]); w.y = pk2(x[2], x[3]);
                            *(u32x2*)(P + (size_t)row * PP + colbase + 32 * bj + 16 * n) = w; }
                }
        }
    }
};
struct EpiHyT {
    static constexpr bool PERM = false, AFTER_DRAIN = false;
    bf16* PT;
    __device__ __forceinline__ void operator()(const pg8::f32x4 (&acc)[2][2][4][2], const pg8::Unit& u, int wr, int wc, int fr, int fq) const {
#pragma unroll
        for (int bj = 0; bj < 2; ++bj)
#pragma unroll
            for (int n = 0; n < 2; ++n) { const int col = u.pn * 256 + wc * 64 + 32 * bj + 16 * n + fr;
#pragma unroll
                for (int ai = 0; ai < 2; ++ai)
#pragma unroll
                    for (int m = 0; m < 4; ++m) { const int row = u.pm * 256 + ai * 128 + wr * 64 + m * 16 + 4 * fq; const pg8::f32x4 x = acc[ai][bj][m][n];
                        u32x2 w; w.x = pk2(x[0], x[1]); w.y = pk2(x[2], x[3]); *(u32x2*)(PT + (size_t)col * MALL + row) = w; } }
    }
};
struct EpiRes {
    static constexpr bool PERM = false, AFTER_DRAIN = false;
    float* xlat; float* xctx; const float* gate;
    __device__ __forceinline__ void operator()(const pg8::f32x4 (&acc)[2][2][4][2], const pg8::Unit& u, int wr, int wc, int fr, int fq) const {
        const int r = u.pm < 32 ? 0 : u.pm < 64 ? 1 : 2;
        float* xb = u.pm < 64 ? xlat + (size_t)u.pm * 256 * DM : xctx + (size_t)(u.pm - 64) * 256 * DM;
        const int col0 = u.pn * 256 + wc * 32 + 4 * fq;
        pg8::f32x4 gv[2][2];
#pragma unroll
        for (int bj = 0; bj < 2; ++bj)
#pragma unroll
            for (int n = 0; n < 2; ++n) gv[bj][n] = *(const pg8::f32x4*)(gate + r * 12288 + col0 + 128 * bj + 16 * n);
#pragma unroll
        for (int ai = 0; ai < 2; ++ai)
#pragma unroll
            for (int m = 0; m < 4; ++m) { float* rp = xb + (size_t)(ai * 128 + wr * 64 + m * 16 + fr) * DM + col0;
#pragma unroll
                for (int bj = 0; bj < 2; ++bj)
#pragma unroll
                    for (int n = 0; n < 2; ++n) { pg8::f32x4* p = (pg8::f32x4*)(rp + 128 * bj + 16 * n); *p = *p + gv[bj][n] * acc[ai][bj][m][n]; } }
    }
};

namespace att {
using bf16x8 = __attribute__((ext_vector_type(8))) short;
using s16x4 = __attribute__((ext_vector_type(4))) short;
using f32x16 = __attribute__((ext_vector_type(16))) float;
using u32x4 = __attribute__((ext_vector_type(4))) unsigned;
constexpr int KVBLK = 64, QBLK = 32;
constexpr float THR2 = 8.f;
constexpr float NEGBIG = -1e30f;
#define KSWZ64(row, colB) ((row) * 128 + ((colB) ^ ((((row) >> 1) & 7) << 4)))
#define ASBAR() __builtin_amdgcn_sched_barrier(0)
__device__ __forceinline__ int crow(int r, int hi) { return (r & 3) + 8 * (r >> 2) + 4 * hi; }
__device__ __forceinline__ unsigned cvtpk(float lo, float hi) { unsigned r; asm volatile("v_cvt_pk_bf16_f32 %0, %1, %2" : "=v"(r) : "v"(lo), "v"(hi)); return r; }
template <int DV> __device__ __forceinline__ int v_st(int k, int c) { const int kk = (k & ~0xC) | ((k & 4) << 1) | ((k & 8) >> 1); return ((kk >> 3) * (DV / 32) + (c >> 5)) * 512 + ((kk & 7) * 32 + (c & 31)) * 2; }
__device__ __forceinline__ int v_rd_base(int lane) { return ((lane & 3) << 3) | (((lane >> 2) & 3) << 6) | (((lane >> 4) & 1) << 5) | (((lane >> 5) & 1) << 8); }
template <int DV> constexpr int v_rd_off(int d0, int ks, int half) { return d0 * 512 + ks * (DV * 32) + half * (DV * 16); }
template <int OFF> __device__ __forceinline__ s16x4 tr_read(int vb) { s16x4 r; asm volatile("ds_read_b64_tr_b16 %0, %1 offset:%2" : "=&v"(r) : "v"(vb), "i"(OFF) : "memory"); return r; }

__device__ __forceinline__ void partialSM(f32x16& p0, f32x16& p1, float& m_reg, float& mn, float& alpha) {
    float pmax = p0[0];
#pragma unroll
    for (int r = 1; r < 16; ++r) pmax = fmaxf(pmax, p0[r]);
#pragma unroll
    for (int r = 0; r < 16; ++r) pmax = fmaxf(pmax, p1[r]);
    { auto rr = __builtin_amdgcn_permlane32_swap(__float_as_uint(pmax), __float_as_uint(pmax), false, false); pmax = fmaxf(__uint_as_float(rr[0]), __uint_as_float(rr[1])); }
    if (__builtin_expect(__all(pmax - m_reg <= THR2), 1)) { mn = m_reg; alpha = 1.f; }
    else { mn = fmaxf(m_reg, pmax); alpha = __builtin_amdgcn_exp2f(m_reg - mn); m_reg = mn; }
#pragma unroll
    for (int r = 0; r < 16; ++r) p0[r] = __builtin_amdgcn_exp2f(p0[r] - mn);
#pragma unroll
    for (int r = 0; r < 16; ++r) p1[r] = p1[r] - mn;
}
__device__ __forceinline__ void finishSM(f32x16& p0, f32x16& p1, float alpha, float& l_reg, bf16x8& pa0, bf16x8& pa1, bf16x8& pa2, bf16x8& pa3) {
#pragma unroll
    for (int r = 0; r < 16; ++r) p1[r] = __builtin_amdgcn_exp2f(p1[r]);
    float ps = 0;
#pragma unroll
    for (int r = 0; r < 16; ++r) ps += p0[r];
#pragma unroll
    for (int r = 0; r < 16; ++r) ps += p1[r];
    { auto rr = __builtin_amdgcn_permlane32_swap(__float_as_uint(ps), __float_as_uint(ps), false, false); ps = __uint_as_float(rr[0]) + __uint_as_float(rr[1]); }
    l_reg = l_reg * alpha + ps;
#define PK4(P, BASE, OUT) do { unsigned a0 = cvtpk(P[BASE + 0], P[BASE + 1]), a1 = cvtpk(P[BASE + 2], P[BASE + 3]);   \
    unsigned b0 = cvtpk(P[BASE + 4], P[BASE + 5]), b1 = cvtpk(P[BASE + 6], P[BASE + 7]);                              \
    auto r0 = __builtin_amdgcn_permlane32_swap(a0, b0, false, false); auto r1 = __builtin_amdgcn_permlane32_swap(a1, b1, false, false); \
    u32x4 w = {r0[0], r1[0], r0[1], r1[1]}; OUT = *reinterpret_cast<bf16x8*>(&w); } while (0)
    PK4(p0, 0, pa0); PK4(p0, 8, pa1); PK4(p1, 0, pa2); PK4(p1, 8, pa3);
#undef PK4
}
__device__ __forceinline__ void qkt(f32x16& p0, f32x16& p1, const char* Ks, const bf16x8* qr, int r32, int hi) {
    p0 = f32x16{}; p1 = f32x16{};
#pragma unroll
    for (int d0 = 0; d0 < 4; ++d0) { const int cb = (d0 * 16 + hi * 8) * 2;
        const bf16x8 b0 = *reinterpret_cast<const bf16x8*>(Ks + KSWZ64(r32, cb));
        const bf16x8 b1 = *reinterpret_cast<const bf16x8*>(Ks + KSWZ64(32 + r32, cb));
        p0 = __builtin_amdgcn_mfma_f32_32x32x16_bf16(b0, qr[d0], p0, 0, 0, 0);
        p1 = __builtin_amdgcn_mfma_f32_32x32x16_bf16(b1, qr[d0], p1, 0, 0, 0); }
}
template <int DV, int D0> __device__ __forceinline__ void pv_one(f32x16& od, int vb, bf16x8 pa0, bf16x8 pa1, bf16x8 pa2, bf16x8 pa3) {
    const s16x4 l0 = tr_read<v_rd_off<DV>(D0, 0, 0)>(vb), h0 = tr_read<v_rd_off<DV>(D0, 0, 1)>(vb), l1 = tr_read<v_rd_off<DV>(D0, 1, 0)>(vb), h1 = tr_read<v_rd_off<DV>(D0, 1, 1)>(vb);
    const s16x4 l2 = tr_read<v_rd_off<DV>(D0, 2, 0)>(vb), h2 = tr_read<v_rd_off<DV>(D0, 2, 1)>(vb), l3 = tr_read<v_rd_off<DV>(D0, 3, 0)>(vb), h3 = tr_read<v_rd_off<DV>(D0, 3, 1)>(vb);
    asm volatile("s_waitcnt lgkmcnt(0)" ::: "memory"); ASBAR();
#define PK(L, H) (bf16x8){L[0], L[1], L[2], L[3], H[0], H[1], H[2], H[3]}
    od = __builtin_amdgcn_mfma_f32_32x32x16_bf16(pa0, PK(l0, h0), od, 0, 0, 0);
    od = __builtin_amdgcn_mfma_f32_32x32x16_bf16(pa1, PK(l1, h1), od, 0, 0, 0);
    od = __builtin_amdgcn_mfma_f32_32x32x16_bf16(pa2, PK(l2, h2), od, 0, 0, 0);
    od = __builtin_amdgcn_mfma_f32_32x32x16_bf16(pa3, PK(l3, h3), od, 0, 0, 0);
#undef PK
}
template <int DV> __device__ __forceinline__ void pv_all(f32x16* o, int vb, bf16x8 pa0, bf16x8 pa1, bf16x8 pa2, bf16x8 pa3) {
    pv_one<DV, 0>(o[0], vb, pa0, pa1, pa2, pa3); pv_one<DV, 1>(o[1], vb, pa0, pa1, pa2, pa3);
    if constexpr (DV == 128) { pv_one<DV, 2>(o[2], vb, pa0, pa1, pa2, pa3); pv_one<DV, 3>(o[3], vb, pa0, pa1, pa2, pa3); }
}
struct KeyMap { const bf16* kc; const bf16* vc; const bf16* kl; const bf16* vl; int q0m128; int band; };
template <bool BAND> __device__ __forceinline__ void key_ptrs(const KeyMap& km, int t, int i, const bf16*& kp, const bf16*& vp) {
    if (t < 4) { const size_t o = (size_t)(64 * t + i) * PP; kp = km.kc + o; vp = km.vc + o; }
    else { int kpos = 64 * (t - 4) + i; if (BAND && km.band) { kpos += km.q0m128; kpos = kpos < 0 ? 0 : (kpos > SEQ - 1 ? SEQ - 1 : kpos); } const size_t o = (size_t)kpos * PP; kp = km.kl + o; vp = km.vl + o; }
}
__device__ __forceinline__ void band_mask(f32x16& p0, f32x16& p1, const KeyMap& km, int t, int qpos, int hi) {
    if (km.band && t >= 4) { const int kb = km.q0m128 + 64 * (t - 4);
#pragma unroll
        for (int r = 0; r < 16; ++r) { const int k0 = kb + crow(r, hi), k1 = k0 + 32; const int d0 = k0 - qpos, d1 = k1 - qpos;
            const bool v0 = (k0 >= 0) && (k0 < SEQ) && (d0 <= 128) && (d0 >= -128), v1 = (k1 >= 0) && (k1 < SEQ) && (d1 <= 128) && (d1 >= -128);
            p0[r] = v0 ? p0[r] : NEGBIG; p1[r] = v1 ? p1[r] : NEGBIG; } }
}
template <int DV> constexpr int shm_bytes() { return 2 * 8192 + 2 * 64 * DV * 2 + NWAVES * 256; }
template <int DV, bool BAND, int SD>
__device__ __forceinline__ void attn_pass(const bf16* __restrict__ Qb, const KeyMap km, int NT, int q0, f32x16 (&o)[DV / 32], float& l_out, float& m_out, char* lds) {
    constexpr int SHM_K = 8192, SHM_V = 64 * DV * 2, NV = DV / 64;
    int tid_ = threadIdx.x; asm volatile("" : "+v"(tid_));
    const int tid = tid_, wid = tid >> 6, lane = tid & 63, r32 = lane & 31, hi = lane >> 5;
    char* V_lds = lds; char* K_lds = lds + 2 * SHM_V;
    float* wsf = (float*)(lds + WSF_OFF) + wid * 64; float* al_l = wsf + 32;
    float m_reg = NEGBIG, l_reg = 0.f; bf16x8 qr[4];
#pragma unroll
    for (int d = 0; d < DV / 32; ++d) o[d] = f32x16{};
    const bf16* Qw = Qb + (size_t)(wid * QBLK + r32) * PP + hi * 8;
#pragma unroll
    for (int d0 = 0; d0 < 4; ++d0) qr[d0] = *reinterpret_cast<const bf16x8*>(Qw + d0 * 16);
    const int kr = tid >> 3, kc8 = (tid & 7) * 8;
    const int sr = tid >> 4, sc = (tid & 15) * 8;
    const int kst = KSWZ64(kr, kc8 * 2);
    const int vst0 = (DV == 128) ? v_st<DV>(sr, sc) : v_st<DV>(kr, kc8), vst1 = (DV == 128) ? v_st<DV>(32 + sr, sc) : 0;
    const int vb0 = (int)(uintptr_t)V_lds + v_rd_base(lane);
    const int qpos = q0 + wid * QBLK + r32;
    struct { bf16x8 k, v0, v1; } st[SD];
    constexpr int SO = SD - 1;
#define SLOAD(i, t) do { const bf16 *kp_, *vp_; key_ptrs<BAND>(km, (t), kr, kp_, vp_); st[i].k = *reinterpret_cast<const bf16x8*>(kp_ + kc8); \
        if constexpr (NV == 1) { st[i].v0 = *reinterpret_cast<const bf16x8*>(vp_ + kc8); } \
        else { key_ptrs<BAND>(km, (t), sr, kp_, vp_); st[i].v0 = *reinterpret_cast<const bf16x8*>(vp_ + sc); key_ptrs<BAND>(km, (t), 32 + sr, kp_, vp_); st[i].v1 = *reinterpret_cast<const bf16x8*>(vp_ + sc); } } while (0)
#define SWRITE(b, i) do { *(bf16x8*)(K_lds + (b) * SHM_K + kst) = st[i].k; *(bf16x8*)(V_lds + (b) * SHM_V + vst0) = st[i].v0; \
        if constexpr (NV == 2) { *(bf16x8*)(V_lds + (b) * SHM_V + vst1) = st[i].v1; } } while (0)
#define SWAIT() do { if constexpr (SD == 1) asm volatile("s_waitcnt vmcnt(0)" ::: "memory"); else if constexpr (NV == 2) asm volatile("s_waitcnt vmcnt(3)" ::: "memory"); else asm volatile("s_waitcnt vmcnt(2)" ::: "memory"); } while (0)
#define RESC(a) do { if (__any((a) < 1.f)) { if (hi == 0) al_l[r32] = (a); asm volatile("s_waitcnt lgkmcnt(0)" ::: "memory"); \
        _Pragma("unroll") for (int d = 0; d < DV / 32; ++d) _Pragma("unroll") for (int r = 0; r < 16; ++r) o[d][r] *= al_l[crow(r, hi)]; } } while (0)
    f32x16 pA0, pA1, pB0, pB1; float mnA, mnB, alA, alB; bf16x8 pa0, pa1, pa2, pa3;
    SLOAD(0, 0); asm volatile("s_waitcnt vmcnt(0)" ::: "memory"); SWRITE(0, 0); __syncthreads();
    qkt(pA0, pA1, K_lds, qr, r32, hi); if constexpr (BAND) band_mask(pA0, pA1, km, 0, qpos, hi); partialSM(pA0, pA1, m_reg, mnA, alA);
    SLOAD(SO, 1); if constexpr (SD == 2) { if (2 < NT) SLOAD(0, 2); }
    SWAIT(); SWRITE(1, SO); __syncthreads();
    for (int j = 1; j + 1 < NT; j += 2) {
        ASBAR(); qkt(pB0, pB1, K_lds + SHM_K, qr, r32, hi); if constexpr (BAND) band_mask(pB0, pB1, km, j, qpos, hi);
        finishSM(pA0, pA1, alA, l_reg, pa0, pa1, pa2, pa3); ASBAR();
        SLOAD(SO, j + SD); ASBAR();
        pv_all<DV>(o, vb0, pa0, pa1, pa2, pa3); partialSM(pB0, pB1, m_reg, mnB, alB);
        __syncthreads(); SWAIT(); SWRITE(0, 0);
        RESC(alB); __syncthreads();
        ASBAR(); qkt(pA0, pA1, K_lds, qr, r32, hi); if constexpr (BAND) band_mask(pA0, pA1, km, j + 1, qpos, hi);
        finishSM(pB0, pB1, alB, l_reg, pa0, pa1, pa2, pa3); ASBAR();
        if (SD == 1 || j + 3 < NT) SLOAD(0, j + 1 + SD); ASBAR();
        pv_all<DV>(o, vb0 + SHM_V, pa0, pa1, pa2, pa3); partialSM(pA0, pA1, m_reg, mnA, alA);
        __syncthreads(); SWAIT(); SWRITE(1, SO);
        RESC(alA); __syncthreads();
    }
    ASBAR(); qkt(pB0, pB1, K_lds + SHM_K, qr, r32, hi); if constexpr (BAND) band_mask(pB0, pB1, km, NT - 1, qpos, hi);
    finishSM(pA0, pA1, alA, l_reg, pa0, pa1, pa2, pa3); ASBAR();
    pv_all<DV>(o, vb0, pa0, pa1, pa2, pa3); partialSM(pB0, pB1, m_reg, mnB, alB);
    __syncthreads(); RESC(alB);
    finishSM(pB0, pB1, alB, l_reg, pa0, pa1, pa2, pa3); ASBAR();
    pv_all<DV>(o, vb0 + SHM_V, pa0, pa1, pa2, pa3);
    l_out = l_reg; m_out = m_reg;
    __syncthreads();
#undef SLOAD
#undef SWRITE
#undef SWAIT
#undef RESC
}
template <int DV> __device__ __forceinline__ void stage_o(const f32x16 (&o)[DV / 32], float* stg, int r32, int hi) {
    float* b = stg + 4 * hi * DV + r32;
#pragma unroll
    for (int d0 = 0; d0 < DV / 32; ++d0)
#pragma unroll
        for (int r = 0; r < 16; ++r) b[((r & 3) + 8 * (r >> 2)) * DV + 32 * d0] = o[d0][r];
}
#undef KSWZ64
#undef ASBAR
}

constexpr size_t WS_ASCR_CTX = 1133 * MiB;
__device__ __forceinline__ void attnA_unit(Frame& F, int l, int b, int h, int qb, int stash_slot) {
    const bf16* P = WSP(bf16, WS_P); bf16* MIX = WSP(bf16, WS_MIX);
    const int lane = F.lane, r32 = lane & 31, hi = lane >> 5, wid = F.wave;
    const size_t crow0 = (size_t)NLAT + (size_t)b * CTX, lrow0 = (size_t)b * SEQ;
    const size_t qrow0 = qb < 0 ? crow0 : lrow0 + (size_t)qb * 256;
    const int NT = qb < 0 ? 4 : 4 + SEQ / 64;
    float* wsf = (float*)(F.ldsg + WSF_OFF) + wid * 64; float* stg = (float*)(F.ldsg + wid * 16384);
    f32x4* scr = (qb < 0 ? WSP(f32x4, WS_ASCR_CTX) : WSP(f32x4, WS_ASCR)) + ((size_t)stash_slot * 512 + F.tid) * 16;
    const int row = lane >> 1, half = lane & 1;
#pragma unroll 1
    for (int comp = 0; comp < 2; ++comp) {
        att::f32x16 o[4]; float l_, m_;
        const att::KeyMap km{P + crow0 * PP + OFF_KA + h * 128 + comp * 64, P + crow0 * PP + OFF_VA + h * 128, P + lrow0 * PP + OFF_KA + h * 128 + comp * 64, P + lrow0 * PP + OFF_VA + h * 128, 0, 0};
        att::attn_pass<128, false, 1>(P + qrow0 * PP + OFF_QA + h * 128 + comp * 64, km, NT, 0, o, l_, m_, F.ldsg);
        att::stage_o<128>(o, stg, r32, hi);
        if (hi == 0) wsf[r32] = l_;
        asm volatile("s_waitcnt lgkmcnt(0)" ::: "memory");
        const float rl = 1.0f / wsf[row];
        const f32x4* sp = (const f32x4*)(stg + row * 128 + half * 64);
        if (comp == 0) {
#pragma unroll
            for (int j = 0; j < 16; ++j) scr[j] = sp[j] * rl;
        } else {
            const float lam = WSP(float, WS_LAMB)[l];
            f32x4 f[16]; float ss = 0.f;
#pragma unroll
            for (int j = 0; j < 16; ++j) { f[j] = scr[j] - (sp[j] * rl) * lam; ss += (f[j].x * f[j].x + f[j].y * f[j].y) + (f[j].z * f[j].z + f[j].w * f[j].w); }
            ss += __shfl_xor(ss, 1);
            const float rstd = (1.0f / sqrtf(ss * (1.f / 128.f) + RMS_EPS)) * (1.0f - (0.8f - 0.6f * __expf(-0.3f * (float)l)));
            const f32x4* gp = (const f32x4*)(F.a->in[I_SUBLN] + l * 128 + half * 64);
            v4u* dst = (v4u*)(MIX + (qrow0 + wid * 32 + row) * DM + h * 128 + half * 64);
#pragma unroll
            for (int j = 0; j < 8; ++j) { const f32x4 a = f[2 * j] * gp[2 * j] * rstd, c = f[2 * j + 1] * gp[2 * j + 1] * rstd;
                dst[j] = (v4u){pk2(a.x, a.y), pk2(a.z, a.w), pk2(c.x, c.y), pk2(c.z, c.w)}; }
        }
        asm volatile("s_waitcnt lgkmcnt(0)" ::: "memory"); __syncthreads();
    }
}
__device__ __forceinline__ void attnB_unit(Frame& F, int l, int b, int hq, int qb) {
    const bf16* P = WSP(bf16, WS_P); bf16* MIX = WSP(bf16, WS_MIX);
    const int lane = F.lane, r32 = lane & 31, hi = lane >> 5, wid = F.wave, kvh = hq >> 2;
    const size_t crow0 = (size_t)NLAT + (size_t)b * CTX, lrow0 = (size_t)b * SEQ;
    const size_t qrow0 = qb < 0 ? crow0 : lrow0 + (size_t)qb * 256;
    const int NT = qb < 0 ? 4 : 12;
    float* wsf = (float*)(F.ldsg + WSF_OFF) + wid * 64; float* stg = (float*)(F.ldsg + wid * 8192);
    const att::KeyMap km{P + crow0 * PP + OFF_KB + kvh * 64, P + crow0 * PP + OFF_VB + kvh * 64, P + lrow0 * PP + OFF_KB + kvh * 64, P + lrow0 * PP + OFF_VB + kvh * 64, qb * 256 - 128, qb >= 0 ? 1 : 0};
    att::f32x16 o[2]; float l_, m_;
    att::attn_pass<64, true, 2>(P + qrow0 * PP + OFF_QB + hq * 64, km, NT, qb < 0 ? 0 : qb * 256, o, l_, m_, F.ldsg);
    l_ += __builtin_amdgcn_exp2f(F.a->in[I_SINK][l * 8 + hq] * 1.4426950408889634f - m_);
    att::stage_o<64>(o, stg, r32, hi);
    if (hi == 0) wsf[r32] = l_;
    asm volatile("s_waitcnt lgkmcnt(0)" ::: "memory");
    const int row = lane >> 1, half = lane & 1;
    const float rl = 1.0f / wsf[row];
    const f32x4* sp = (const f32x4*)(stg + row * 64 + half * 32);
    v4u* dst = (v4u*)(MIX + (qrow0 + wid * 32 + row) * DM + 512 + hq * 64 + half * 32);
#pragma unroll
    for (int j = 0; j < 4; ++j) { const f32x4 a = sp[2 * j] * rl, c = sp[2 * j + 1] * rl; dst[j] = (v4u){pk2(a.x, a.y), pk2(a.z, a.w), pk2(c.x, c.y), pk2(c.z, c.w)}; }
    asm volatile("s_waitcnt lgkmcnt(0)" ::: "memory"); __syncthreads();
}
__device__ __forceinline__ void pool_unit(Frame& F, int l, int s, int ck, int g) {
    const bf16* P = WSP(bf16, WS_P); bf16* MIX = WSP(bf16, WS_MIX);
    float* uf = (float*)F.ldsg; float* dl = uf + 80 * 128;
    const int Ls = s < 2 ? SEQ : CTX; const size_t rowbase = s < 2 ? (size_t)s * SEQ : (size_t)NLAT + (size_t)(s - 2) * CTX; const int t0 = ck * 64;
    for (int ch = F.tid; ch < 80 * 16; ch += 512) { const int row = ch >> 4, c8 = (ch & 15) * 8, t = t0 - 8 + row;
        v4u w = {0u, 0u, 0u, 0u}; if (t >= 0 && t < Ls) w = *(const GAS v4u*)(P + (rowbase + t) * PP + OFF_POOL + g * 128 + c8);
        float* d = uf + row * 128 + c8; d[0] = bflo(w.x); d[1] = bfhi(w.x); d[2] = bflo(w.y); d[3] = bfhi(w.y); d[4] = bflo(w.z); d[5] = bfhi(w.z); d[6] = bflo(w.w); d[7] = bfhi(w.w); }
    __syncthreads();
    const int c = F.tid & 127, tq = F.tid >> 7, wdw = 2 << g, lo = wdw >> 1;
    for (int tt = 0; tt < 16; ++tt) { const int t = tq * 16 + tt, T = t0 + t; int st = T - lo, en = T + wdw - lo; st = st < 0 ? 0 : st; en = en > Ls ? Ls : en;
        float sum = 0.f; for (int ti = st; ti < en; ++ti) sum += uf[(ti - t0 + 8) * 128 + c];
        dl[t * 132 + c] = sum / (float)(en - st) - uf[(t + 8) * 128 + c]; }
    __syncthreads();
    float acc[16];
#pragma unroll
    for (int tt = 0; tt < 16; ++tt) acc[tt] = 0.f;
    const float* W = F.a->in[I_POOLW] + ((size_t)(l * 4 + g) * 128) * 128 + c;
    for (int k4 = 0; k4 < 32; ++k4) { const float w0 = W[(4 * k4) * 128], w1 = W[(4 * k4 + 1) * 128], w2 = W[(4 * k4 + 2) * 128], w3 = W[(4 * k4 + 3) * 128];
#pragma unroll
        for (int tt = 0; tt < 16; ++tt) { const f32x4 d = *(const f32x4*)(dl + (tq * 16 + tt) * 132 + 4 * k4); acc[tt] += d.x * w0 + d.y * w1 + d.z * w2 + d.w * w3; } }
    const float ls = F.a->in[I_POOLS][l * 512 + g * 128 + c];
#pragma unroll
    for (int tt = 0; tt < 16; ++tt) MIX[(rowbase + t0 + tq * 16 + tt) * DM + 1024 + g * 128 + c] = (bf16)f2bf(acc[tt] * ls);
    __syncthreads();
}
__device__ __forceinline__ void hyena_ctx_unit(Frame& F, int l, int b, int ch) {
    const bf16* PT = WSP(bf16, WS_PT); bf16* MIX = WSP(bf16, WS_MIX);
    float* zs = (float*)(F.ldsg + F.wave * 4096); float* kc = zs + 256;
    const float* cw = F.a->in[I_HCW] + (size_t)l * 3 * HYC; const float* cb = F.a->in[I_HCB] + (size_t)l * HYC;
    const size_t tb = (size_t)NLAT + (size_t)b * CTX;
    const bf16* pv = PT + (size_t)ch * MALL + tb; const bf16* p1 = PT + (size_t)(512 + ch) * MALL + tb; const bf16* p2 = PT + (size_t)(1024 + ch) * MALL + tb;
    float zr[4], x2r[4];
#pragma unroll
    for (int i = 0; i < 4; ++i) { const int s = F.lane + 64 * i; const bool hp = s > 0, hn = s < CTX - 1;
        const float v = cw[ch] * (hp ? bf2f(pv[s - 1]) : 0.f) + cw[HYC + ch] * bf2f(pv[s]) + cw[2 * HYC + ch] * (hn ? bf2f(pv[s + 1]) : 0.f) + cb[ch];
        const float x1 = cw[512 + ch] * (hp ? bf2f(p1[s - 1]) : 0.f) + cw[HYC + 512 + ch] * bf2f(p1[s]) + cw[2 * HYC + 512 + ch] * (hn ? bf2f(p1[s + 1]) : 0.f) + cb[512 + ch];
        x2r[i] = cw[1024 + ch] * (hp ? bf2f(p2[s - 1]) : 0.f) + cw[HYC + 1024 + ch] * bf2f(p2[s]) + cw[2 * HYC + 1024 + ch] * (hn ? bf2f(p2[s + 1]) : 0.f) + cb[1024 + ch];
        zr[i] = v * x1; zs[s] = zr[i]; }
    const float* kcg = WSP(float, WS_KC) + ((size_t)l * 512 + ch) * 512;
#pragma unroll
    for (int i = 0; i < 8; ++i) kc[F.lane + 64 * i] = kcg[F.lane + 64 * i];
    asm volatile("s_waitcnt lgkmcnt(0)" ::: "memory");
    float y[4] = {0.f, 0.f, 0.f, 0.f};
    for (int s = 0; s < CTX; ++s) { const float z = zs[s];
#pragma unroll
        for (int i = 0; i < 4; ++i) y[i] += kc[(F.lane + 64 * i - s) & 511] * z; }
    const float bias = F.a->in[I_HBIAS][l * 512 + ch];
#pragma unroll
    for (int i = 0; i < 4; ++i) MIX[(tb + F.lane + 64 * i) * DM + 1536 + ch] = (bf16)f2bf(x2r[i] * (y[i] + bias * zr[i]));
    asm volatile("s_waitcnt lgkmcnt(0)" ::: "memory");
}
__device__ __forceinline__ void hy_load8(const bf16* p, int t0, float (&x)[10]) {
    const v4u w = *(const GAS v4u*)(p + t0);
    x[1] = bflo(w.x); x[2] = bfhi(w.x); x[3] = bflo(w.y); x[4] = bfhi(w.y); x[5] = bflo(w.z); x[6] = bfhi(w.z); x[7] = bflo(w.w); x[8] = bfhi(w.w);
    x[0] = t0 > 0 ? bf2f(p[t0 - 1]) : 0.f; x[9] = t0 + 8 < SEQ ? bf2f(p[t0 + 8]) : 0.f;
}
__device__ __forceinline__ void hyena_lat_unit(Frame& F, int l, int ch) {
    const bf16* PT = WSP(bf16, WS_PT); bf16* MIX = WSP(bf16, WS_MIX);
    f32x2* X = (f32x2*)F.ldsg; float* Xf = (float*)F.ldsg;
    const float* cw = F.a->in[I_HCW] + (size_t)l * 3 * HYC; const float* cb = F.a->in[I_HCB] + (size_t)l * HYC;
    const float wv0 = cw[ch], wv1 = cw[HYC + ch], wv2 = cw[2 * HYC + ch], bv = cb[ch];
    const float wa0 = cw[512 + ch], wa1 = cw[HYC + 512 + ch], wa2 = cw[2 * HYC + 512 + ch], ba = cb[512 + ch];
    const float wb0 = cw[1024 + ch], wb1 = cw[HYC + 1024 + ch], wb2 = cw[2 * HYC + 1024 + ch], bb = cb[1024 + ch];
#pragma unroll 1
    for (int it = F.tid; it < 2048; it += 512) { const int b = it >> 10, t0 = (it & 1023) * 8; const size_t tb = (size_t)b * SEQ;
        float xv[10], xa[10]; hy_load8(PT + (size_t)ch * MALL + tb, t0, xv); hy_load8(PT + (size_t)(512 + ch) * MALL + tb, t0, xa);
#pragma unroll
        for (int i = 0; i < 8; ++i) { const float v = wv0 * xv[i] + wv1 * xv[i + 1] + wv2 * xv[i + 2] + bv, a = wa0 * xa[i] + wa1 * xa[i + 1] + wa2 * xa[i + 2] + ba; Xf[2 * (t0 + i) + b] = v * a; } }
#pragma unroll
    for (int k = 0; k < 16; ++k) X[SEQ + F.tid + 512 * k] = (f32x2){0.f, 0.f};
    __syncthreads();
#pragma unroll 1
    for (int s = 0; s < 7; ++s) { fft_stage_fwd<512>(X, s, F.tid); __syncthreads(); }
    const f32x2* kf = WSP(f32x2, WS_KF) + ((size_t)l * 512 + ch) * NFFT;
#pragma unroll 8
    for (int k = 0; k < 32; ++k) { const int i = F.tid + 512 * k; const f32x2 a = X[i], w = kf[i]; X[i] = (f32x2){a.x * w.x - a.y * w.y, a.x * w.y + a.y * w.x}; }
    __syncthreads();
#pragma unroll 1
    for (int s = 6; s >= 0; --s) { fft_stage_inv<512>(X, s, F.tid); __syncthreads(); }
    const float bias = F.a->in[I_HBIAS][l * 512 + ch];
#pragma unroll 1
    for (int it = F.tid; it < 2048; it += 512) { const int b = it >> 10, t0 = (it & 1023) * 8; const size_t tb = (size_t)b * SEQ;
        float xv[10], xa[10], xb[10]; hy_load8(PT + (size_t)ch * MALL + tb, t0, xv); hy_load8(PT + (size_t)(512 + ch) * MALL + tb, t0, xa); hy_load8(PT + (size_t)(1024 + ch) * MALL + tb, t0, xb);
#pragma unroll
        for (int i = 0; i < 8; ++i) { const float v = wv0 * xv[i] + wv1 * xv[i + 1] + wv2 * xv[i + 2] + bv, a = wa0 * xa[i] + wa1 * xa[i + 1] + wa2 * xa[i + 2] + ba, x2 = wb0 * xb[i] + wb1 * xb[i + 1] + wb2 * xb[i + 2] + bb;
            const float z = v * a, y = Xf[2 * (t0 + i) + b];
            MIX[(tb + t0 + i) * DM + 1536 + ch] = (bf16)f2bf(x2 * (y + bias * z)); } }
    __syncthreads();
}

#ifndef MK_GSP2
#define MK_GSP2 true
#endif
#ifndef MK_GALIGN
#define MK_GALIGN true
#endif
__global__ void __launch_bounds__(NWAVES * 64, 2) fwd_kernel(Args args) {
    extern __shared__ __attribute__((aligned(16))) unsigned char lds[];
    Frame F;
    F.lds = (LAS unsigned char*)lds; F.ldsg = (char*)lds;
    F.MISC = (volatile LAS unsigned*)(F.lds + MISC_OFF);
    F.tid = threadIdx.x; F.lane = F.tid & 63; F.wave = __builtin_amdgcn_readfirstlane(F.tid >> 6);
    F.G = gridDim.x; { const int bx = blockIdx.x; F.vcu = (F.G % 8 == 0) ? (bx % 8) * (F.G / 8) + bx / 8 : bx; }
    F.gw = F.vcu * NWAVES + F.wave; F.NGW = F.G * NWAVES;
    F.a = (const Args __attribute__((address_space(4)))*)__builtin_amdgcn_kernarg_segment_ptr();
    F.ctl = (gu32*)(args.ws + WS_CTL);
    for (int u = F.tid; u < (LDS_BYTES - SCR_OFF) / 4; u += NWAVES * 64) ((LAS unsigned*)(F.lds + SCR_OFF))[u] = 0u;
    __syncthreads();
    XcdBarrier bar = xcd_barrier_post((unsigned*)(F.ctl + CW_BAR), F.MISC + 8);
    const int bid = blockIdx.x, G = F.G;

#ifndef MK_PH
#define MK_PH 0xFFFF
#endif
#define PH(k) F.tid = threadIdx.x; asm volatile("" : "+v"(F.tid), "+s"(F.a) :: "memory"); F.lane = F.tid & 63; if ((MK_PH >> (k)) & 1)
    PH(0) prologue_a(F); xcd_barrier(bar);
    PH(1) prologue_b(F); xcd_barrier(bar);
    PH(2) prologue_c(F); xcd_barrier(bar);

#pragma unroll 1
    for (int l = 0; l < DEPTH; ++l) {
        const bool last = (l == DEPTH - 1);
        const int MR = last ? NLAT : MALL;
        const float* mod = WSP(float, WS_MOD) + (size_t)l * 3 * 12288;
        PH(3) norm_phase(F, l, 0, MALL); xcd_barrier(bar);
        PH(4) { pg8::Gemm g{WSP(bf16, WS_H), WSP(bf16, WS_WIN) + (size_t)l * INC * DM, MALL, PP, DM}; pg8::StaticOrder S; S.init(MALL, PP, G, bid);
          EpiInProj E{WSP(bf16, WS_P), F.a->in[I_QKG] + l * 256, WSP(float, WS_ROPE)};
          pg8::gemm_phase<EpiInProj, pg8::StaticOrder, MK_GALIGN, MK_GSP2, false>(F.lds, g, S, E); }
        PH(5) { pg8::Gemm g{WSP(bf16, WS_H), WSP(bf16, WS_WIN) + (size_t)l * INC * DM + (size_t)PP * DM, MALL, HYC, DM}; pg8::StaticOrder S; S.init(MALL, HYC, G, bid);
          EpiHyT E{WSP(bf16, WS_PT)};
          pg8::gemm_phase<EpiHyT, pg8::StaticOrder, MK_GALIGN, MK_GSP2, true>(F.lds, g, S, E); }
        xcd_barrier(bar);
        PH(6) for (int i = F.vcu; i < 256; i += G) attnA_unit(F, l, i >> 7, (i >> 5) & 3, i & 31, i);
        PH(7) for (int i = F.vcu; i < 512; i += G) attnB_unit(F, l, i >> 8, (i >> 5) & 7, i & 31);
        PH(8) for (int i = F.vcu; i < 512; i += G) hyena_lat_unit(F, l, i);
        PH(9) { const int npool = last ? 1024 : 1056;
          for (int i = bid; i < npool; i += G) { const int g = i & 3, c = i >> 2; if (c < 256) pool_unit(F, l, c >> 7, c & 127, g); else pool_unit(F, l, 2 + ((c - 256) >> 2), (c - 256) & 3, g); } }
        PH(10) if (!last) {
            for (int i = bid; i < 8; i += G) attnA_unit(F, l, i >> 2, i & 3, -1, i);
            for (int i = bid - 8; i >= 0 && i < 16; i += G) attnB_unit(F, l, i >> 3, i & 7, -1);
            for (int i = F.gw; i < 1024; i += F.NGW) hyena_ctx_unit(F, l, i >> 9, i & 511);
            __syncthreads();
        }
        xcd_barrier(bar);
        PH(11) { pg8::Gemm g{WSP(bf16, WS_MIX), WSP(bf16, WS_WOUT) + (size_t)l * DM * DM, MR, DM, DM}; pg8::StaticOrder S; S.init(MR, DM, G, bid);
          EpiRes E{F.a->out, WSP(float, WS_CTXW), mod + 2 * DM};
          pg8::gemm_phase<EpiRes, pg8::StaticOrder, MK_GALIGN, MK_GSP2, false>(F.lds, g, S, E); }
        xcd_barrier(bar);
        PH(12) norm_phase(F, l, 1, MR); xcd_barrier(bar);
        PH(13) { pg8::Gemm g{WSP(bf16, WS_H), WSP(bf16, WS_WF1) + (size_t)l * F2 * DM, MR, F2, DM}; pg8::StaticOrder S; S.init(MR, F2, G, bid);
          pg8::EpiBf16<0> E{WSP(bf16, WS_U), F2, nullptr, 0, 0, 1.f};
          pg8::gemm_phase<pg8::EpiBf16<0>, pg8::StaticOrder, MK_GALIGN, MK_GSP2, false>(F.lds, g, S, E); }
        xcd_barrier(bar);
        PH(14) convact_phase(F, l, MR); xcd_barrier(bar);
        PH(15) { pg8::Gemm g{WSP(bf16, WS_A), WSP(bf16, WS_WF2) + (size_t)l * DM * FH, MR, DM, FH}; pg8::StaticOrder S; S.init(MR, DM, G, bid);
          EpiRes E{F.a->out, WSP(float, WS_CTXW), mod + 5 * DM};
          pg8::gemm_phase<EpiRes, pg8::StaticOrder, MK_GALIGN, MK_GSP2, false>(F.lds, g, S, E); }
        if (!last) xcd_barrier(bar);
    }
}

extern "C" void kernel_launch(void* const* d_in, const int* in_sizes, int n_in, void* d_out, int out_size, void* d_ws, size_t ws_size, hipStream_t stream) {
    static int grid = 0;
    if (grid == 0) {
        if (n_in != 29 || in_sizes[0] != NLAT * DM || out_size != NLAT * DM || ws_size < WS_END) {
            fprintf(stderr, "kernel_launch: built for 29 inputs, x/out of %d floats, >= %zu bytes of workspace; got n_in %d, in0 %d, out %d, ws %zu; nothing launched\n", NLAT * DM, (size_t)WS_END, n_in, n_in > 0 ? in_sizes[0] : -1, out_size, ws_size); grid = -1; return; }
        int dev = 0, cus = 0, per_cu = 0;
        if (hipGetDevice(&dev) != hipSuccess || hipDeviceGetAttribute(&cus, hipDeviceAttributeMultiprocessorCount, dev) != hipSuccess) { fprintf(stderr, "kernel_launch: device query failed\n"); grid = -1; return; }
        if (hipFuncSetAttribute((const void*)fwd_kernel, hipFuncAttributeMaxDynamicSharedMemorySize, LDS_BYTES) != hipSuccess) { fprintf(stderr, "kernel_launch: hipFuncSetAttribute failed\n"); grid = -1; return; }
        if (hipOccupancyMaxActiveBlocksPerMultiprocessor(&per_cu, (const void*)fwd_kernel, NWAVES * 64, LDS_BYTES) != hipSuccess || per_cu < 1)
            fprintf(stderr, "kernel_launch: note: occupancy query reports %d workgroups per CU\n", per_cu);
        (void)hipGetLastError();
        grid = cus;
        fprintf(stderr, "kernel_launch: grid %d, occupancy query %d\n", grid, per_cu);
    }
    if (grid < 0) return;
    if (hipMemsetAsync((char*)d_ws + WS_CTL, 0, CTL_ZERO_BYTES, stream) != hipSuccess) { fprintf(stderr, "kernel_launch: memset failed\n"); return; }
    Args a{};
    for (int i = 0; i < 29; ++i) a.in[i] = (const float*)d_in[i];
    a.out = (float*)d_out; a.ws = (unsigned char*)d_ws;
    hipLaunchKernelGGL(fwd_kernel, dim3(grid), dim3(NWAVES * 64), LDS_BYTES, stream, a);
    const hipError_t le = hipPeekAtLastError();
    if (le != hipSuccess) fprintf(stderr, "kernel_launch: launch failed: %s\n", hipGetErrorName(le));
}
```

```cpp
#include <hip/hip_runtime.h>
#include <cstdio>
#include <cstdint>
namespace pg8 {
#define PG8_LAS __attribute__((address_space(3)))
typedef unsigned short bf16_t;
typedef short bf16x8 __attribute__((ext_vector_type(8)));
typedef float f32x4 __attribute__((ext_vector_type(4)));
typedef unsigned u32x4 __attribute__((ext_vector_type(4)));
constexpr int BM = 256, BK = 64, HALF = 128, HTB = HALF * BK * 2  , STAGE_BYTES = 8 * HTB, NXCD = 8, WGM = 8;

__host__ __device__ __forceinline__ int lds_byte(int r, int c) { const int st = (r >> 4) * 2 + (c >> 5), rr = r & 15, cc = c & 31, ob = rr * 64 + cc * 2; return st * 1024 + (ob ^ (((ob >> 9) & 1) << 5)); }
__host__ __device__ __forceinline__ void stage_rc(int b, int& R, int& C) { const int st = b / 1024, sb = b % 1024, swz = sb ^ (((sb >> 9) & 1) << 5); R = (st >> 1) * 16 + swz / 64; C = (st & 1) * 32 + (swz % 64) / 2; }
__host__ __device__ __forceinline__ int perm32(int rho) { const int n = rho >> 4, i = rho & 15; return 8 * (i >> 2) + 4 * n + (i & 3); }

struct Unit { int pm, pn, koff; };
struct Gemm { const bf16_t* A; const bf16_t* Bt; int M, N, K, ld; };

struct StaticOrder {
    int nM, nN, nwg, G, c;
    __host__ __device__ void init(int M, int N, int G_, int c_) { nM = M / BM; nN = N / BM; nwg = nM * nN; G = G_; c = c_; }
    __host__ __device__ bool next(int i, Unit& u) const {
        const long L = (long)i * G + c; if (L >= nwg) return false;
        int wgid = (int)L; { const int q = nwg / NXCD, r = nwg % NXCD, xcd = wgid % NXCD, off = wgid / NXCD; wgid = (xcd < r ? xcd * (q + 1) : r * (q + 1) + (xcd - r) * q) + off; }
        const int nig = WGM * nN, gid = wgid / nig, fm = gid * WGM, gsz = (nM - fm) < WGM ? (nM - fm) : WGM;
        u.pm = fm + ((wgid % nig) % gsz); u.pn = (wgid % nig) / gsz; u.koff = 0; return true;
    }
    __device__ __forceinline__ void a_ready(const Unit&) const {}
    __device__ __forceinline__ void done(const Unit&) const {}
};

__device__ __forceinline__ unsigned cvt_pk_bf16(float lo, float hi) { unsigned r; asm volatile("v_cvt_pk_bf16_f32 %0, %1, %2" : "=v"(r) : "v"(lo), "v"(hi)); return r; }
typedef float f32x2 __attribute__((ext_vector_type(2)));
__device__ __forceinline__ f32x2 gelu_pk(f32x2 v) {
    const f32x2 av = __builtin_elementwise_abs(v), d = av * 0.2316418882f + 1.0f;
    f32x2 t; t.x = __builtin_amdgcn_rcpf(d.x); t.y = __builtin_amdgcn_rcpf(d.y);
    f32x2 q = t * 0.5307027145f + (-0.7265760135f); q = q * t + 0.7107068705f; q = q * t + (-0.142248368f); q = q * t + 0.127414796f; q = q * t;
    const f32x2 s = (v * v) * (-0.72134752044f);
    f32x2 e; e.x = __builtin_amdgcn_exp2f(s.x); e.y = __builtin_amdgcn_exp2f(s.y);
    const f32x2 m = v * (q * e), r = v - m;
    f32x2 o; o.x = v.x < 0.f ? m.x : r.x; o.y = v.y < 0.f ? m.y : r.y; return o;
}

template <int ACT  > struct EpiBf16 {
    static constexpr bool PERM = true, AFTER_DRAIN = false; static_assert(ACT == 0 || ACT == 1, "EpiBf16: ACT is 0 (none) or 1 (gelu_pk)");
    bf16_t* O; int ldc; const float* bias; int split_cols; size_t split_stride; float scale0;
    __device__ __forceinline__ void operator()(const f32x4 (&acc)[2][2][4][2], const Unit& u, int wr, int wc, int fr, int fq) const {
        const int row0 = u.pm * BM + wr * 64 + fr; int colt = u.pn * BM; bf16_t* base = O;
        float sc = 1.f; if (split_cols) { const int t = colt / split_cols; base += (size_t)t * split_stride; colt -= t * split_cols; if (t == 0) sc = scale0; }
        const int col0 = colt + wc * 32 + 8 * fq, bcol0 = u.pn * BM + wc * 32 + 8 * fq;
        f32x4 bv[2][2];
#pragma unroll
        for (int bj = 0; bj < 2; ++bj)
#pragma unroll
            for (int n = 0; n < 2; ++n) bv[bj][n] = bias ? *(const f32x4*)(bias + bcol0 + bj * HALF + 4 * n) : (f32x4){0.f, 0.f, 0.f, 0.f};
#pragma unroll
        for (int ai = 0; ai < 2; ++ai)
#pragma unroll
            for (int m = 0; m < 4; ++m) { bf16_t* rowp = base + (size_t)(row0 + ai * HALF + m * 16) * ldc + col0;
#pragma unroll
                for (int bj = 0; bj < 2; ++bj) { f32x4 v0 = acc[ai][bj][m][0] + bv[bj][0], v1 = acc[ai][bj][m][1] + bv[bj][1];
                    if (ACT == 1) { f32x2 a = gelu_pk((f32x2){v0[0], v0[1]}), b = gelu_pk((f32x2){v0[2], v0[3]}), c = gelu_pk((f32x2){v1[0], v1[1]}), d = gelu_pk((f32x2){v1[2], v1[3]});
                        v0 = (f32x4){a.x, a.y, b.x, b.y}; v1 = (f32x4){c.x, c.y, d.x, d.y}; }
                    v0 = v0 * sc; v1 = v1 * sc; u32x4 w; w.x = cvt_pk_bf16(v0[0], v0[1]); w.y = cvt_pk_bf16(v0[2], v0[3]); w.z = cvt_pk_bf16(v1[0], v1[1]); w.w = cvt_pk_bf16(v1[2], v1[3]);
                    *(u32x4*)(rowp + bj * HALF) = w; } }
    }
};

template <class Epi, class Sched, bool ALIGN_EPI = false, bool SP2 = false, bool SWAP = false>
__device__ __forceinline__ void gemm_phase(PG8_LAS unsigned char* lds, const Gemm g, const Sched& S, const Epi& E) {
    int tid_ = threadIdx.x; asm volatile("" : "+v"(tid_));
    const int tid = tid_, wid = __builtin_amdgcn_readfirstlane(tid >> 6), lane = tid & 63, wr = wid >> 2, wc = wid & 3, fr = lane & 15, fq = lane >> 4;
    const int K = g.ld, nt = g.K / BK;
    unsigned voffA[2], voffB[2];
#pragma unroll
    for (int i = 0; i < 2; ++i) { int R, C; stage_rc(tid * 16 + i * 8192, R, C); const int Rb = Epi::PERM ? ((R & ~31) + perm32(R & 31)) : R;
        voffA[i] = (unsigned)(R * K + C) * 2u; voffB[i] = (unsigned)(Rb * K + C) * 2u; }
    const size_t kstep = (size_t)(BK * 2);
    const size_t hstep = (size_t)HALF * K * 2;
    const size_t tstep = 2 * hstep;
    const unsigned ldsw = (unsigned)wid * 1024u;
    const int aoff = lds_byte(wr * 64 + fr, fq * 8), boff = lds_byte(wc * 32 + fr, fq * 8);
#define PG8_SA(b, h) (((b) * 2 + (h)) * HTB)
#define PG8_SB(b, h) ((4 + (b) * 2 + (h)) * HTB)
#define PG8_STAGE(bufoff, gbase, voff) do { _Pragma("unroll") for (int _i = 0; _i < 2; ++_i) \
        __builtin_amdgcn_global_load_lds((const unsigned*)((const char*)(gbase) + (voff)[_i]), (PG8_LAS unsigned*)(lds + (bufoff) + ldsw + _i * 8192), 16, 0, 0); } while (0)
#define PG8_LDA(dst, b, h) do { _Pragma("unroll") for (int m = 0; m < 4; ++m) _Pragma("unroll") for (int k = 0; k < 2; ++k) dst[m][k] = *(const PG8_LAS bf16x8*)(lds + PG8_SA(b, h) + aoff + m * 2048 + k * 1024); } while (0)
#define PG8_LDB(dst, b, h) do { _Pragma("unroll") for (int n = 0; n < 2; ++n) _Pragma("unroll") for (int k = 0; k < 2; ++k) dst[n][k] = *(const PG8_LAS bf16x8*)(lds + PG8_SB(b, h) + boff + n * 2048 + k * 1024); } while (0)
#define PG8_MMA(ai, bj, At, Bt) do { __builtin_amdgcn_s_setprio(1); _Pragma("unroll") for (int m = 0; m < 4; ++m) _Pragma("unroll") for (int n = 0; n < 2; ++n) _Pragma("unroll") for (int k = 0; k < 2; ++k) \
        acc[ai][bj][m][n] = SWAP ? __builtin_amdgcn_mfma_f32_16x16x32_bf16(At[m][k], Bt[n][k], acc[ai][bj][m][n], 0, 0, 0) : __builtin_amdgcn_mfma_f32_16x16x32_bf16(Bt[n][k], At[m][k], acc[ai][bj][m][n], 0, 0, 0); __builtin_amdgcn_s_setprio(0); } while (0)
#define PG8_WAIT_V(n) asm volatile("s_waitcnt vmcnt(" #n ")" ::: "memory")
#define PG8_WAIT_L(n) asm volatile("s_waitcnt lgkmcnt(" #n ")" ::: "memory")
#define PG8_BAR __builtin_amdgcn_s_barrier()
#define PG8_SCHED __builtin_amdgcn_sched_barrier(0)
    Unit cur, nxt; int ui = 0;
    if (!S.next(0, cur)) return;
    f32x4 acc[2][2][4][2];
#pragma unroll
    for (int a = 0; a < 2; ++a)
#pragma unroll
        for (int b = 0; b < 2; ++b)
#pragma unroll
            for (int m = 0; m < 4; ++m)
#pragma unroll
                for (int n = 0; n < 2; ++n) acc[a][b][m][n] = (f32x4){0.f, 0.f, 0.f, 0.f};
    bf16x8 At[4][2], B0[2][2], B1[2][2];
    const char* cA = (const char*)g.A + (size_t)cur.pm * tstep + (size_t)cur.koff * 2; const char* cB = (const char*)g.Bt + (size_t)cur.pn * tstep + (size_t)cur.koff * 2;
    S.a_ready(cur);
    if constexpr (SP2) {
        PG8_STAGE(PG8_SB(0, 0), cB, voffB); PG8_STAGE(PG8_SB(0, 1), cB + hstep, voffB); PG8_STAGE(PG8_SA(0, 0), cA, voffA); PG8_STAGE(PG8_SA(0, 1), cA + hstep, voffA);
        if (wr == 1) PG8_BAR;
        PG8_WAIT_V(2); PG8_BAR;
        PG8_STAGE(PG8_SB(1, 0), cB + kstep, voffB); PG8_STAGE(PG8_SA(1, 0), cA + kstep, voffA); PG8_STAGE(PG8_SB(1, 1), cB + hstep + kstep, voffB);
        PG8_WAIT_V(6); PG8_BAR;
    } else {
        PG8_STAGE(PG8_SB(0, 0), cB, voffB); PG8_STAGE(PG8_SA(0, 0), cA, voffA); PG8_STAGE(PG8_SB(0, 1), cB + hstep, voffB); PG8_STAGE(PG8_SA(0, 1), cA + hstep, voffA);
        if (wr == 1) PG8_BAR;
        PG8_WAIT_V(4); PG8_BAR;
        PG8_STAGE(PG8_SB(1, 0), cB + kstep, voffB); PG8_STAGE(PG8_SA(1, 0), cA + kstep, voffA); PG8_STAGE(PG8_SB(1, 1), cB + hstep + kstep, voffB);
        PG8_WAIT_V(6); PG8_BAR;
    }
    for (;;) {
        const bool has_next = S.next(ui + 1, nxt);
        const char* nA = has_next ? (const char*)g.A + (size_t)nxt.pm * tstep + (size_t)nxt.koff * 2 : cA; const char* nB = has_next ? (const char*)g.Bt + (size_t)nxt.pn * tstep + (size_t)nxt.koff * 2 : cB;
        for (int t = 0; t < nt; t += 2) {
            const bool last = (t == nt - 2);
            const char* a1 = cA + (size_t)(t + 1) * kstep;
            const char* a2 = last ? nA : cA + (size_t)(t + 2) * kstep; const char* b2 = last ? nB : cB + (size_t)(t + 2) * kstep;
            const char* a3 = a2 + kstep; const char* b3 = b2 + kstep;
            if (last && has_next) S.a_ready(nxt);
            if constexpr (SP2) {
            PG8_LDB(B0, 0, 0); PG8_LDB(B1, 0, 1); PG8_SCHED; PG8_LDA(At, 0, 0); PG8_STAGE(PG8_SA(1, 1), a1 + hstep, voffA);
            PG8_WAIT_V(8); PG8_WAIT_L(0); PG8_BAR; PG8_MMA(0, 0, At, B0); PG8_MMA(0, 1, At, B1); PG8_BAR; PG8_SCHED;
            PG8_LDA(At, 0, 1); PG8_STAGE(PG8_SB(0, 0), b2, voffB); PG8_STAGE(PG8_SB(0, 1), b2 + hstep, voffB); PG8_STAGE(PG8_SA(0, 0), a2, voffA);
            PG8_WAIT_V(8); PG8_WAIT_L(0); PG8_BAR; PG8_MMA(1, 0, At, B0); PG8_MMA(1, 1, At, B1); PG8_BAR; PG8_SCHED;
            PG8_LDB(B0, 1, 0); PG8_LDB(B1, 1, 1); PG8_SCHED; PG8_LDA(At, 1, 0); PG8_STAGE(PG8_SA(0, 1), a2 + hstep, voffA);
            PG8_WAIT_V(8); PG8_WAIT_L(0); PG8_BAR; PG8_MMA(0, 0, At, B0); PG8_MMA(0, 1, At, B1); PG8_BAR; PG8_SCHED;
            PG8_LDA(At, 1, 1); PG8_STAGE(PG8_SB(1, 0), b3, voffB); PG8_STAGE(PG8_SB(1, 1), b3 + hstep, voffB); PG8_STAGE(PG8_SA(1, 0), a3, voffA);
            PG8_WAIT_V(8); PG8_WAIT_L(0); PG8_BAR; PG8_MMA(1, 0, At, B0); PG8_MMA(1, 1, At, B1); PG8_BAR; PG8_SCHED;
            } else {
            PG8_LDB(B0, 0, 0); PG8_SCHED; PG8_LDA(At, 0, 0); PG8_STAGE(PG8_SA(1, 1), a1 + hstep, voffA);
            PG8_WAIT_L(8); PG8_BAR; PG8_WAIT_L(0); PG8_MMA(0, 0, At, B0); PG8_BAR; PG8_SCHED;
            PG8_LDB(B1, 0, 1); PG8_STAGE(PG8_SB(0, 0), b2, voffB);
            PG8_BAR; PG8_WAIT_L(0); PG8_MMA(0, 1, At, B1); PG8_BAR;
            PG8_LDA(At, 0, 1); PG8_STAGE(PG8_SA(0, 0), a2, voffA);
            PG8_BAR; PG8_WAIT_L(0); PG8_MMA(1, 0, At, B0); PG8_BAR; PG8_SCHED;
            PG8_STAGE(PG8_SB(0, 1), b2 + hstep, voffB);
            PG8_WAIT_V(6); PG8_BAR; PG8_MMA(1, 1, At, B1); PG8_BAR;
            PG8_LDB(B0, 1, 0); PG8_SCHED; PG8_LDA(At, 1, 0); PG8_STAGE(PG8_SA(0, 1), a2 + hstep, voffA);
            PG8_WAIT_L(8); PG8_BAR; PG8_WAIT_L(0); PG8_MMA(0, 0, At, B0); PG8_BAR; PG8_SCHED;
            PG8_LDB(B1, 1, 1); PG8_STAGE(PG8_SB(1, 0), b3, voffB);
            PG8_BAR; PG8_WAIT_L(0); PG8_MMA(0, 1, At, B1); PG8_BAR;
            PG8_LDA(At, 1, 1); PG8_STAGE(PG8_SA(1, 0), a3, voffA);
            PG8_BAR; PG8_WAIT_L(0); PG8_MMA(1, 0, At, B0); PG8_BAR; PG8_SCHED;
            PG8_STAGE(PG8_SB(1, 1), b3 + hstep, voffB);
            PG8_WAIT_V(6); PG8_BAR; PG8_MMA(1, 1, At, B1); PG8_BAR;
            }
        }
        if constexpr (ALIGN_EPI) { if (wr == 0) PG8_BAR; }
        if constexpr (!Epi::AFTER_DRAIN) { E(acc, cur, wr, wc, fr, fq); S.done(cur); }
        if (!has_next) break;
#pragma unroll
        for (int a = 0; a < 2; ++a)
#pragma unroll
            for (int b = 0; b < 2; ++b)
#pragma unroll
                for (int m = 0; m < 4; ++m)
#pragma unroll
                    for (int n = 0; n < 2; ++n) acc[a][b][m][n] = (f32x4){0.f, 0.f, 0.f, 0.f};
        cur = nxt; cA = nA; cB = nB; ++ui;
        if constexpr (ALIGN_EPI) { if (wr == 1) PG8_BAR; }
    }
    PG8_WAIT_V(0);
    if constexpr (!ALIGN_EPI) { if (wr == 0) PG8_BAR; }
    PG8_BAR;
    if constexpr (Epi::AFTER_DRAIN) { E.fused(acc, cur, wr, wc, fr, fq, lds, wid, lane); S.done(cur); }
#undef PG8_SA
#undef PG8_SB
#undef PG8_STAGE
#undef PG8_LDA
#undef PG8_LDB
#undef PG8_MMA
#undef PG8_WAIT_V
#undef PG8_WAIT_L
#undef PG8_BAR
#undef PG8_SCHED
}
}
#define GAS __attribute__((address_space(1)))
#define LAS __attribute__((address_space(3)))
typedef unsigned short bf16;
typedef unsigned v4u __attribute__((ext_vector_type(4)));
typedef float f32x4 __attribute__((ext_vector_type(4)));
typedef short bf16x8 __attribute__((ext_vector_type(8)));
typedef GAS unsigned gu32;
typedef GAS unsigned long long gu64;
#define RLX_AGENT __ATOMIC_RELAXED, __HIP_MEMORY_SCOPE_AGENT
#define LDS_WAIT() asm volatile("s_waitcnt lgkmcnt(0)" ::: "memory")
#define VM_WAIT() asm volatile("s_waitcnt vmcnt(0)" ::: "memory")
__device__ __forceinline__ unsigned long long rt() { return __builtin_amdgcn_s_memrealtime(); }
__device__ __forceinline__ unsigned f2bf(float f) { unsigned u = __builtin_bit_cast(unsigned, f); return (u + 0x7fffu + ((u >> 16) & 1u)) >> 16; }
__device__ __forceinline__ unsigned pk2(float lo, float hi) { return f2bf(lo) | (f2bf(hi) << 16); }

#define XB_TMO      128
#define XB_XCNT(j)  (256  + 64 * (j))
#define XB_XSUB(j)  (1280 + 64 * (j))
#define XB_XGEN(j)  (2304 + 64 * (j))
#define XB_TOP      3328
#define XB_TOPGEN   3392
#define XCD_BAR_WORDS 3456
#define XB_SPIN_CAP (1u << 18)

__device__ __forceinline__ unsigned xb_ld(unsigned* p)              { return __hip_atomic_load(p, __ATOMIC_RELAXED, __HIP_MEMORY_SCOPE_AGENT); }
__device__ __forceinline__ unsigned xb_add(unsigned* p, unsigned v) { return __hip_atomic_fetch_add(p, v, __ATOMIC_RELAXED, __HIP_MEMORY_SCOPE_AGENT); }
__device__ __forceinline__ unsigned xb_xcc_id() { return (unsigned)__builtin_amdgcn_s_getreg((3 << 11) | 20) & 0xFu; }
#define XB_SPIN(cond, bar) do { unsigned _sp = 0; while (cond) { __builtin_amdgcn_s_sleep(1); \
    if ((++_sp & 255u) == 0u) { if (xb_ld(&(bar)[XB_TMO])) break; if (_sp > XB_SPIN_CAP) { atomicAdd(&(bar)[XB_TMO], 1u); break; } } } } while (0)

struct XcdBarrier {
    unsigned* bar; unsigned x;
    volatile LAS unsigned* st;
};

__device__ __forceinline__ XcdBarrier xcd_barrier_post(unsigned* bar, volatile LAS unsigned* st) {
    XcdBarrier b; b.bar = bar; b.x = xb_xcc_id(); b.st = st;
    if (threadIdx.x == 0) (void)xb_add(&bar[XB_XCNT(b.x)], 1u);
    return b;
}
__device__ __forceinline__ void xcd_barrier_complete(unsigned* bar, unsigned x, unsigned& nloc, unsigned& nx) {
    const unsigned G = gridDim.x * gridDim.y * gridDim.z;
    unsigned sum, cnt, mine, sp = 0u;
    for (;;) {
        sum = 0u; cnt = 0u; mine = 0u;
#pragma unroll
        for (unsigned j = 0; j < 16; ++j) { const unsigned c = xb_ld(&bar[XB_XCNT(j)]); sum += c; cnt += (c > 0u) ? 1u : 0u; mine = (j == x) ? c : mine; }
        if (sum == G) break;
        __builtin_amdgcn_s_sleep(1);
        if ((++sp & 255u) == 0u) { if (xb_ld(&bar[XB_TMO])) break; if (sp > XB_SPIN_CAP) { atomicAdd(&bar[XB_TMO], 1u); break; } }
    }
    nloc = mine > 0u ? mine : 1u; nx = cnt > 0u ? cnt : 1u;
}

__device__ __forceinline__ void xcd_barrier(const XcdBarrier& b) {
    asm volatile("s_waitcnt vmcnt(0)" ::: "memory");
    __syncthreads();
    if (threadIdx.x == 0) {
        unsigned* bar = b.bar;
        __builtin_amdgcn_s_waitcnt(0);
        unsigned nloc = b.st[0], nx = b.st[1];
        if (nloc == 0u) { xcd_barrier_complete(bar, b.x, nloc, nx); b.st[0] = nloc; b.st[1] = nx; }
        const unsigned old = xb_add(&bar[XB_XSUB(b.x)], 1u);
        const unsigned gen = old / nloc;
        if (old + 1u == (gen + 1u) * nloc) {
            __builtin_amdgcn_fence(__ATOMIC_RELEASE, "agent");
            asm volatile("s_waitcnt vmcnt(0)" ::: "memory");
            const unsigned og = xb_add(&bar[XB_TOP], 1u);
            const unsigned tg = og / nx;
            if (og + 1u == (tg + 1u) * nx) xb_add(&bar[XB_TOPGEN], 1u);
            else XB_SPIN(xb_ld(&bar[XB_TOPGEN]) == tg, bar);
            __builtin_amdgcn_fence(__ATOMIC_ACQUIRE, "agent");
            xb_add(&bar[XB_XGEN(b.x)], 1u);
            asm volatile("s_waitcnt vmcnt(0)" ::: "memory");
        } else {
            XB_SPIN(xb_ld(&bar[XB_XGEN(b.x)]) == gen, bar);
            __builtin_amdgcn_fence(__ATOMIC_ACQUIRE, "agent");
            asm volatile("s_waitcnt vmcnt(0)" ::: "memory");
        }
    }
    __syncthreads();
}

constexpr int DM = 2048, NB = 2, SEQ = 8192, CTX = 256, DEPTH = 4;
constexpr int NLAT = NB * SEQ, NCTXR = NB * CTX, MALL = NLAT + NCTXR;
constexpr int INC = 4352, PP = 2816, HYC = 1536;
constexpr int FH = 5632, F2 = 11264;
constexpr int OFF_QA = 0, OFF_KA = 512, OFF_VA = 1024, OFF_QB = 1536, OFF_KB = 2048, OFF_VB = 2176, OFF_POOL = 2304;
constexpr int NFFT = 16384;
constexpr float QSCALE = 0.125f * 1.4426950408889634f;
constexpr float RMS_EPS = 1e-6f;
constexpr int MODKS = 8;

constexpr size_t MiB = 1u << 20;
constexpr size_t WS_CTL = 0, CTL_ZERO_BYTES = 2 * MiB;
constexpr size_t WS_MOD = 2 * MiB;
constexpr size_t WS_ROPE = 3 * MiB;
constexpr size_t WS_LAMB = 3 * MiB + 65536;
constexpr size_t WS_MODP = 4 * MiB;
constexpr size_t WS_KC = 9 * MiB;
constexpr size_t WS_CTXW = 13 * MiB;
constexpr size_t WS_HID = 17 * MiB;
constexpr size_t WS_HIDC = 25 * MiB;
constexpr size_t WS_WIN = 26 * MiB;
constexpr size_t WS_WOUT = 94 * MiB;
constexpr size_t WS_WF1 = 126 * MiB;
constexpr size_t WS_WF2 = 302 * MiB;
constexpr size_t WS_KF = 390 * MiB;
constexpr size_t WS_H = 646 * MiB;
constexpr size_t WS_A = 712 * MiB;
constexpr size_t WS_U = 894 * MiB;
constexpr size_t WS_P = 894 * MiB;
constexpr size_t WS_PT = 985 * MiB;
constexpr size_t WS_MIX = 1035 * MiB;
constexpr size_t WS_ASCR = 1101 * MiB;
constexpr size_t WS_KRAW = 894 * MiB;
constexpr size_t WS_KCRAW = 1030 * MiB;
constexpr size_t WS_SLAB = 1257 * MiB;
constexpr size_t WS_END = 1301 * MiB;
static_assert(WS_MOD + 4 * 3 * 12288 * 4 <= WS_ROPE && WS_MODP + (size_t)MODKS * 4 * 3 * 12288 * 4 <= WS_KC && WS_KC + 4u * 512 * 512 * 4 <= WS_CTXW, "ws map 1");
static_assert(WS_WIN + (size_t)4 * INC * DM * 2 <= WS_WOUT && WS_WF1 + (size_t)4 * F2 * DM * 2 <= WS_WF2 && WS_WF2 + (size_t)4 * DM * FH * 2 <= WS_KF, "ws map 2");
static_assert(WS_KF + (size_t)4 * 512 * NFFT * 8 <= WS_H && WS_H + (size_t)MALL * DM * 2 <= WS_A && WS_A + (size_t)MALL * FH * 2 <= WS_U && WS_U + (size_t)MALL * F2 * 2 <= WS_SLAB && WS_SLAB + (size_t)11 * NCTXR * DM * 4 <= WS_END, "ws map 3");
static_assert(WS_P + (size_t)MALL * PP * 2 <= WS_PT && WS_PT + (size_t)HYC * MALL * 2 <= WS_MIX && WS_MIX + (size_t)MALL * DM * 2 <= WS_ASCR && WS_ASCR + 32 * MiB <= WS_END, "ws map 4");
static_assert(WS_KRAW + (size_t)4 * 512 * NFFT * 4 <= WS_KCRAW && WS_KCRAW + 4 * MiB <= WS_END, "ws map 5");
constexpr int CW_BAR = 4096;

constexpr int RING_BYTES = 131072;
constexpr int SCR_OFF = RING_BYTES;
constexpr int WSF_OFF = RING_BYTES + 1024;
constexpr int MISC_OFF = RING_BYTES + 4096;
constexpr int LDS_BYTES = 147456;
constexpr int NWAVES = 8;

typedef float f32x2 __attribute__((ext_vector_type(2)));
typedef unsigned u32x2 __attribute__((ext_vector_type(2)));
__device__ __forceinline__ float bf2f(unsigned short h) { return __builtin_bit_cast(float, (unsigned)h << 16); }
__device__ __forceinline__ float bflo(unsigned w) { return __builtin_bit_cast(float, w << 16); }
__device__ __forceinline__ float bfhi(unsigned w) { return __builtin_bit_cast(float, w & 0xffff0000u); }
__device__ __forceinline__ float wave_sum(float v) {
#pragma unroll
    for (int o = 1; o < 64; o <<= 1) v += __shfl_xor(v, o);
    return v;
}
__host__ __device__ __forceinline__ void sincos_acc(double x, float& s, float& c) {
    const double k = __builtin_rint(x * 0.63661977236758134308);
    const double r = x - k * 1.57079632679489661923;
    const int q = ((int)k) & 3;
    const double r2 = r * r;
    const double sp = r * (1.0 + r2 * (-1.0 / 6 + r2 * (1.0 / 120 + r2 * (-1.0 / 5040 + r2 * (1.0 / 362880 + r2 * (-1.0 / 39916800 + r2 * (1.0 / 6227020800.0)))))));
    const double cp = 1.0 + r2 * (-0.5 + r2 * (1.0 / 24 + r2 * (-1.0 / 720 + r2 * (1.0 / 40320 + r2 * (-1.0 / 3628800 + r2 * (1.0 / 479001600.0))))));
    const double ss = (q == 0) ? sp : (q == 1) ? cp : (q == 2) ? -sp : -cp;
    const double cc = (q == 0) ? cp : (q == 1) ? -sp : (q == 2) ? -cp : sp;
    s = (float)ss; c = (float)cc;
}
__host__ __device__ __forceinline__ void tw_cs(int m, float& c, float& s) {
    const int oct = m >> 11, r = m & 2047;
    const int rr = (oct & 1) ? 2048 - r : r;
    const float a = (float)rr * 3.834951969714103e-4f;
    const float a2 = a * a;
    const float sp = a * (1.f + a2 * (-1.f / 6 + a2 * (1.f / 120 + a2 * (-1.f / 5040 + a2 * (1.f / 362880)))));
    const float cp = 1.f + a2 * (-0.5f + a2 * (1.f / 24 + a2 * (-1.f / 720 + a2 * (1.f / 40320 + a2 * (-1.f / 3628800)))));
    float cc, ss;
    switch (oct) {
        case 0: cc = cp; ss = sp; break;
        case 1: cc = sp; ss = cp; break;
        case 2: cc = -sp; ss = cp; break;
        case 3: cc = -cp; ss = sp; break;
        case 4: cc = -cp; ss = -sp; break;
        case 5: cc = -sp; ss = -cp; break;
        case 6: cc = sp; ss = -cp; break;
        default: cc = cp; ss = -sp; break;
    }
    c = cc; s = ss;
}

template <int THREADS>
__host__ __device__ __forceinline__ void fft_stage_fwd(f32x2* X, int s, int tid) {
    const int lq = 12 - 2 * s, q = 1 << lq;
    for (int b = tid; b < 4096; b += THREADS) {
        const int j = b & (q - 1), grp = b >> lq, base = (grp << (lq + 2)) + j;
        const f32x2 a0 = X[base], a1 = X[base + q], a2 = X[base + 2 * q], a3 = X[base + 3 * q];
        const f32x2 t0 = a0 + a2, t1 = a0 - a2, t2 = a1 + a3;
        const f32x2 d13 = a1 - a3; const f32x2 t3 = {d13.y, -d13.x};
        const f32x2 y0 = t0 + t2, u1 = t1 + t3, u2 = t0 - t2, u3 = t1 - t3;
        float c1, s1; tw_cs((j << (2 * s)) & (NFFT - 1), c1, s1);
        const float c2 = c1 * c1 - s1 * s1, s2 = 2.f * c1 * s1;
        const float c3 = c2 * c1 - s2 * s1, s3 = s2 * c1 + c2 * s1;
        X[base] = y0;
        X[base + q] = (f32x2){u1.x * c1 + u1.y * s1, u1.y * c1 - u1.x * s1};
        X[base + 2 * q] = (f32x2){u2.x * c2 + u2.y * s2, u2.y * c2 - u2.x * s2};
        X[base + 3 * q] = (f32x2){u3.x * c3 + u3.y * s3, u3.y * c3 - u3.x * s3};
    }
}
template <int THREADS>
__host__ __device__ __forceinline__ void fft_stage_inv(f32x2* X, int s, int tid) {
    const int lq = 12 - 2 * s, q = 1 << lq;
    for (int b = tid; b < 4096; b += THREADS) {
        const int j = b & (q - 1), grp = b >> lq, base = (grp << (lq + 2)) + j;
        const f32x2 b0 = X[base], b1 = X[base + q], b2 = X[base + 2 * q], b3 = X[base + 3 * q];
        float c1, s1; tw_cs((j << (2 * s)) & (NFFT - 1), c1, s1);
        const float c2 = c1 * c1 - s1 * s1, s2 = 2.f * c1 * s1;
        const float c3 = c2 * c1 - s2 * s1, s3 = s2 * c1 + c2 * s1;
        const f32x2 e1 = {b1.x * c1 - b1.y * s1, b1.y * c1 + b1.x * s1};
        const f32x2 e2 = {b2.x * c2 - b2.y * s2, b2.y * c2 + b2.x * s2};
        const f32x2 e3 = {b3.x * c3 - b3.y * s3, b3.y * c3 + b3.x * s3};
        const f32x2 t0 = b0 + e2, t1 = b0 - e2, t2 = e1 + e3;
        const f32x2 d13 = e1 - e3; const f32x2 t3 = {-d13.y, d13.x};
        X[base] = t0 + t2;
        X[base + q] = t1 + t3;
        X[base + 2 * q] = t0 - t2;
        X[base + 3 * q] = t1 - t3;
    }
}

struct Args { const float* in[29]; float* out; unsigned char* ws; };
enum InIdx { I_X = 0, I_C, I_CTX, I_CCTX, I_WMOD, I_BMOD, I_N1G, I_N2G, I_WIN, I_WOUT, I_QKG, I_LAM, I_SUBLN, I_SINK, I_POOLW, I_POOLS, I_HCW, I_HCB, I_HW1, I_HB1, I_HW2, I_HB2, I_HW3, I_HFREQ, I_HBIAS, I_FW1, I_FCW, I_FCB, I_FW2 };
struct Frame {
    LAS unsigned char* lds; char* ldsg;
    volatile LAS unsigned* MISC;
    gu32* ctl;
    int tid, lane, wave, vcu, G, gw, NGW;
    const Args __attribute__((address_space(4)))* a;
};
#define WSP(T, off) ((T*)(F.a->ws + (off)))

__device__ __forceinline__ void p0_transpose_item(const float* W, int K, int N, bf16* WT, bool perm, LAS float* scr, int item, int lane) {
    const int nblk = N / 32, kb = item / nblk, nb = item % nblk, k0 = 64 * kb, n0 = 32 * nb;
    float tv[32];
#pragma unroll
    for (int i = 0; i < 32; ++i) tv[i] = W[(size_t)(k0 + 2 * i + (lane >> 5)) * N + n0 + (lane & 31)];
#pragma unroll
    for (int i = 0; i < 32; ++i) scr[(2 * i + (lane >> 5)) * 33 + (lane & 31)] = tv[i];
    LDS_WAIT(); asm volatile("" ::: "memory");
    int orow0 = n0;
    if (perm) { const int tile = n0 >> 8, gl = (n0 >> 5) & 7, wc = gl >> 1, bj = gl & 1; orow0 = tile * 256 + (4 * bj + wc) * 32; }
    const int c = lane & 7;
#pragma unroll
    for (int j = 0; j < 4; ++j) { const int n = (lane >> 3) + 8 * j; const LAS float* s = scr + (8 * c) * 33 + n;
        v4u o; o.x = pk2(s[0 * 33], s[1 * 33]); o.y = pk2(s[2 * 33], s[3 * 33]); o.z = pk2(s[4 * 33], s[5 * 33]); o.w = pk2(s[6 * 33], s[7 * 33]);
        *(GAS v4u*)(WT + (size_t)(orow0 + n) * K + k0 + 8 * c) = o; }
    LDS_WAIT(); asm volatile("" ::: "memory");
}

__device__ __forceinline__ float silu_f(float v) { return v / (1.f + __expf(-v)); }

__device__ __forceinline__ void prologue_a(Frame& F) {
    LAS float* scr = (LAS float*)(F.lds + F.wave * 16384);
    const int gw = F.gw, NGW = F.NGW, lane = F.lane;
    constexpr int IT_WIN = (DM / 64) * (INC / 32), IT_WOUT = (DM / 64) * (DM / 32), IT_F1 = (DM / 64) * (F2 / 32), IT_F2 = (FH / 64) * (DM / 32), IT_L = IT_WIN + IT_WOUT + IT_F1 + IT_F2;
    for (int it = gw; it < DEPTH * IT_L; it += NGW) {
        const int l = it / IT_L; int r = it % IT_L;
        if (r < IT_WIN) { p0_transpose_item(F.a->in[I_WIN] + (size_t)l * DM * INC, DM, INC, WSP(bf16, WS_WIN) + (size_t)l * INC * DM, true, scr, r, lane); continue; } r -= IT_WIN;
        if (r < IT_WOUT) { p0_transpose_item(F.a->in[I_WOUT] + (size_t)l * DM * DM, DM, DM, WSP(bf16, WS_WOUT) + (size_t)l * DM * DM, false, scr, r, lane); continue; } r -= IT_WOUT;
        if (r < IT_F1) { p0_transpose_item(F.a->in[I_FW1] + (size_t)l * DM * F2, DM, F2, WSP(bf16, WS_WF1) + (size_t)l * F2 * DM, false, scr, r, lane); continue; } r -= IT_F1;
        p0_transpose_item(F.a->in[I_FW2] + (size_t)l * FH * DM, FH, DM, WSP(bf16, WS_WF2) + (size_t)l * DM * FH, false, scr, r, lane);
    }
    {
        const float* cvec = F.a->in[I_C]; const float* cctx = F.a->in[I_CCTX]; const float* wmod = F.a->in[I_WMOD]; float* modp = WSP(float, WS_MODP);
        for (int it = gw; it < DEPTH * 192 * MODKS; it += NGW) {
            const int ks = it % MODKS, cc = (it / MODKS) % 192, l = it / (MODKS * 192), k0 = ks * 256, col = cc * 64 + lane;
#pragma unroll
            for (int i = 0; i < 4; ++i) { const int k = lane + 64 * i;
                scr[k] = silu_f(cvec[k0 + k]); scr[256 + k] = silu_f(cvec[DM + k0 + k]); scr[512 + k] = silu_f(cctx[k0 + k]); }
            LDS_WAIT(); asm volatile("" ::: "memory");
            float a0 = 0.f, a1 = 0.f, a2 = 0.f; const float* wp = wmod + ((size_t)l * DM + k0) * 12288 + col;
#pragma unroll 1
            for (int k0_ = 0; k0_ < 256; k0_ += 32) { float wv[32];
#pragma unroll
                for (int k = 0; k < 32; ++k) wv[k] = wp[(size_t)(k0_ + k) * 12288];
#pragma unroll
                for (int k = 0; k < 32; ++k) { a0 += scr[k0_ + k] * wv[k]; a1 += scr[256 + k0_ + k] * wv[k]; a2 += scr[512 + k0_ + k] * wv[k]; } }
            float* mp = modp + ((size_t)(ks * DEPTH + l) * 3) * 12288 + col; mp[0] = a0; mp[12288] = a1; mp[2 * 12288] = a2;
            LDS_WAIT(); asm volatile("" ::: "memory");
        }
    }
    {
        for (int it = gw; it < 2048 + 64; it += NGW) {
            int l, t0, Ls; float* dst;
            if (it < 2048) { l = it >> 9; t0 = (it & 511) * 16; Ls = SEQ; dst = WSP(float, WS_HID) + ((size_t)l * SEQ + t0) * 64; }
            else { const int j = it - 2048; l = j >> 4; t0 = (j & 15) * 16; Ls = CTX; dst = WSP(float, WS_HIDC) + ((size_t)l * CTX + t0) * 64; }
            const float* w1 = F.a->in[I_HW1] + l * 33 * 64; const float* w2 = F.a->in[I_HW2] + l * 64 * 64;
            const float b1 = F.a->in[I_HB1][l * 64 + lane], b2 = F.a->in[I_HB2][l * 64 + lane], fr = F.a->in[I_HFREQ][l * 64 + lane];
            for (int p = 0; p < 16; ++p) {
                const int t = t0 + p;
                float z = 0.f;
                if (lane == 0) z = (float)t / (float)(Ls - 1);
                else if (lane <= 32) { const int e = (lane - 1) & 15; const float f = 1e-4f + (float)e * ((15.f - 1e-4f) / 15.f); const float wang = 6.283185307179586f * (float)t / (float)Ls;
                    float s, c; sincos_acc((double)(f * wang), s, c); z = (lane <= 16) ? c : -s; }
                float acc = 0.f;
#pragma unroll
                for (int e = 0; e < 33; ++e) acc += __builtin_bit_cast(float, __builtin_amdgcn_readlane(__builtin_bit_cast(int, z), e)) * w1[e * 64 + lane];
                float s1, c1; sincos_acc((double)(fr * (acc + b1)), s1, c1);
                float acc2 = 0.f;
#pragma unroll
                for (int i = 0; i < 64; ++i) acc2 += __builtin_bit_cast(float, __builtin_amdgcn_readlane(__builtin_bit_cast(int, s1), i)) * w2[i * 64 + lane];
                float s2, c2; sincos_acc((double)(fr * (acc2 + b2)), s2, c2);
                dst[p * 64 + lane] = s2;
            }
        }
    }
    for (int e = gw * 64 + lane; e < 128 * 16; e += NGW * 64) { const int pos = e >> 4, f = e & 15;
        double invd = 1.0; for (int q = 0; q < f; ++q) invd *= 0.56234132519034908;     const float inv = (float)invd;
        const float ang = (float)pos * inv; float s, c; sincos_acc((double)ang, s, c);
        WSP(float, WS_ROPE)[2 * e] = c; WSP(float, WS_ROPE)[2 * e + 1] = s; }
    if (gw < DEPTH) { const int l = gw; const float* lp = F.a->in[I_LAM] + l * 256;
        const float s1 = wave_sum(lp[lane] * lp[64 + lane]), s2 = wave_sum(lp[128 + lane] * lp[192 + lane]);
        const float linit = 0.8f - 0.6f * __expf(-0.3f * (float)l);
        if (lane == 0) WSP(float, WS_LAMB)[l] = __expf(s1) - __expf(s2) + linit; }
    {
      const GAS f32x4* cs = (const GAS f32x4*)F.a->in[I_CTX]; GAS f32x4* cd = (GAS f32x4*)WSP(float, WS_CTXW);
      for (size_t i = (size_t)gw * 64 + lane; i < (size_t)NCTXR * DM / 4; i += (size_t)NGW * 64) cd[i] = cs[i]; }
}

__device__ __forceinline__ void prologue_b(Frame& F) {
    { const float* modp = WSP(float, WS_MODP); float* mod = WSP(float, WS_MOD); const float* bm = F.a->in[I_BMOD];
      for (int e = F.gw * 64 + F.lane; e < DEPTH * 3 * 12288; e += F.NGW * 64) { const int col = e % 12288, l = e / (3 * 12288);
          float a = bm[l * 12288 + col];
#pragma unroll
          for (int ks = 0; ks < MODKS; ++ks) a += modp[(size_t)ks * DEPTH * 3 * 12288 + e];
          mod[e] = a; } }
    LAS float* hs = (LAS float*)F.lds; LAS float* wsm = hs + 64 * 65;
    const int tl = F.tid & 63, cy = F.tid >> 6;
    const int NIT_L = DEPTH * 128 * 16, NIT_C = DEPTH * 4 * 16;
    for (int it = blockIdx.x; it < NIT_L + NIT_C; it += F.G) {
        int l, t0, c0, Ls; const float* hid; float* dstbase;
        if (it < NIT_L) { l = it / (128 * 16); const int r = it % (128 * 16); t0 = (r / 16) * 64; c0 = (r % 16) * 64; Ls = SEQ; hid = WSP(float, WS_HID) + ((size_t)l * SEQ + t0) * 64; dstbase = WSP(float, WS_KRAW) + (size_t)l * 512 * NFFT; }
        else { const int j = it - NIT_L; l = j / 64; const int r = j % 64; t0 = (r / 16) * 64; c0 = (r % 16) * 64; Ls = CTX; hid = WSP(float, WS_HIDC) + ((size_t)l * CTX + t0) * 64; dstbase = WSP(float, WS_KCRAW) + (size_t)l * 512 * 512; }
        const float* w3 = F.a->in[I_HW3] + (size_t)l * 64 * 1024 + c0;
#pragma unroll
        for (int k = 0; k < 8; ++k) { const int idx = F.tid + 512 * k, r = idx >> 6, i = idx & 63; hs[r * 65 + i] = hid[idx]; wsm[idx] = w3[(size_t)r * 1024 + i]; }
        __syncthreads();
        float acc[8];
#pragma unroll
        for (int e = 0; e < 8; ++e) acc[e] = 0.f;
#pragma unroll 4
        for (int i = 0; i < 64; ++i) { const float hv = hs[tl * 65 + i]; const f32x4 wa = *(const LAS f32x4*)(wsm + i * 64 + cy * 8), wb = *(const LAS f32x4*)(wsm + i * 64 + cy * 8 + 4);
            acc[0] += hv * wa.x; acc[1] += hv * wa.y; acc[2] += hv * wa.z; acc[3] += hv * wa.w; acc[4] += hv * wb.x; acc[5] += hv * wb.y; acc[6] += hv * wb.z; acc[7] += hv * wb.w; }
        const int t = t0 + tl; const float t01 = (float)t / (float)(Ls - 1);
#pragma unroll
        for (int e = 0; e < 8; ++e) { const int c = c0 + cy * 8 + e, dir = c >> 9, chn = c & 511;
            const float delta = -15.350567286626973f + (-3.0701134573253946f + 15.350567286626973f) * ((float)chn / 511.f);
            float val = acc[e] * __expf(t01 * delta);
            int pos = t; if (dir) { pos = (t == 0) ? Ls : 2 * Ls - t; if (t == 0) val = 0.f; }
            dstbase[(size_t)chn * (2 * Ls) + pos] = val; }
        __syncthreads();
    }
}

__device__ __forceinline__ void prologue_c(Frame& F) {
    f32x2* X = (f32x2*)F.ldsg; float* red = (float*)(F.ldsg + SCR_OFF);
    for (int it = blockIdx.x; it < DEPTH * 512; it += F.G) {
        const float* kr = WSP(float, WS_KRAW) + (size_t)it * NFFT; float v[32]; float ss = 0.f;
#pragma unroll
        for (int k = 0; k < 32; ++k) { v[k] = kr[F.tid + 512 * k]; ss += v[k] * v[k]; }
        ss = wave_sum(ss); if (F.lane == 0) red[F.wave] = ss;
        __syncthreads();
        float tot = 0.f;
#pragma unroll
        for (int w = 0; w < 8; ++w) tot += red[w];
        const float sc = (1.0f / sqrtf(tot + RMS_EPS)) * (1.0f / (float)NFFT);
#pragma unroll
        for (int k = 0; k < 32; ++k) X[F.tid + 512 * k] = (f32x2){v[k] * sc, 0.f};
        __syncthreads();
#pragma unroll 1
        for (int s = 0; s < 7; ++s) { fft_stage_fwd<512>(X, s, F.tid); __syncthreads(); }
        f32x2* kf = WSP(f32x2, WS_KF) + (size_t)it * NFFT;
#pragma unroll
        for (int k = 0; k < 32; ++k) kf[F.tid + 512 * k] = X[F.tid + 512 * k];
        __syncthreads();
    }
    for (int it = F.gw; it < DEPTH * 512; it += F.NGW) {
        const float* kr = WSP(float, WS_KCRAW) + (size_t)it * 512; float v[8]; float ss = 0.f;
#pragma unroll
        for (int k = 0; k < 8; ++k) { v[k] = kr[F.lane + 64 * k]; ss += v[k] * v[k]; }
        const float sc = 1.0f / sqrtf(wave_sum(ss) + RMS_EPS);
        float* kc = WSP(float, WS_KC) + (size_t)it * 512;
#pragma unroll
        for (int k = 0; k < 8; ++k) kc[F.lane + 64 * k] = v[k] * sc;
    }
}

__device__ __forceinline__ void norm_phase(Frame& F, int l, int which, int nrows, int nslab, const float* xlat) {
    const float* g = (which ? F.a->in[I_N2G] : F.a->in[I_N1G]) + l * DM; const float* mod = WSP(float, WS_MOD) + (size_t)l * 3 * 12288;
    const int shoff = which ? 3 * DM : 0, scoff = which ? 4 * DM : DM;
    bf16* H = WSP(bf16, WS_H);
    for (int row = F.gw; row < nrows; row += F.NGW) {
        const int r = row < SEQ ? 0 : row < NLAT ? 1 : 2;
        const float* src = row < NLAT ? xlat + (size_t)row * DM : WSP(float, WS_CTXW) + (size_t)(row - NLAT) * DM;
        const GAS f32x4* xr = (const GAS f32x4*)src + F.lane; f32x4 v[8]; float ss = 0.f;
#pragma unroll
        for (int j = 0; j < 8; ++j) v[j] = xr[64 * j];
        if (row >= NLAT && nslab > 0) {
            const GAS f32x4* sl = (const GAS f32x4*)(WSP(float, WS_SLAB) + (size_t)(row - NLAT) * DM) + F.lane;
            for (int ks = 0; ks < nslab; ++ks) {
#pragma unroll
                for (int j = 0; j < 8; ++j) v[j] = v[j] + sl[(size_t)ks * NCTXR * DM / 4 + 64 * j]; }
            GAS f32x4* xw = (GAS f32x4*)(WSP(float, WS_CTXW) + (size_t)(row - NLAT) * DM) + F.lane;
#pragma unroll
            for (int j = 0; j < 8; ++j) xw[64 * j] = v[j];
        }
#pragma unroll
        for (int j = 0; j < 8; ++j) ss += (v[j].x * v[j].x + v[j].y * v[j].y) + (v[j].z * v[j].z + v[j].w * v[j].w);
        const float rstd = 1.0f / sqrtf(wave_sum(ss) * (1.f / DM) + RMS_EPS);
        GAS u32x2* o8 = (GAS u32x2*)(H + (size_t)row * DM) + F.lane;
#pragma unroll
        for (int j = 0; j < 8; ++j) { const int col = 4 * F.lane + 256 * j;
            const f32x4 gg = *(const f32x4*)(g + col), sc = *(const f32x4*)(mod + r * 12288 + scoff + col), sh = *(const f32x4*)(mod + r * 12288 + shoff + col);
            const f32x4 y = v[j] * rstd * gg * (sc + 1.f) + sh;
            u32x2 w; w.x = pk2(y.x, y.y); w.y = pk2(y.z, y.w); o8[64 * j] = w; }
    }
}

__device__ __forceinline__ void convact_phase(Frame& F, int l, int nrows) {
    const bf16* U = WSP(bf16, WS_U); bf16* A = WSP(bf16, WS_A);
    const float* cw = F.a->in[I_FCW] + (size_t)l * 3 * F2; const float* cb = F.a->in[I_FCB] + (size_t)l * F2;
    const int nrc = nrows / 16;
    for (int it = F.gw; it < nrc * 11; it += F.NGW) {
        const int rc = it / 11, cbk = it % 11, row0 = rc * 16, col = cbk * 512 + F.lane * 8;
        const int seqlen = row0 < NLAT ? SEQ : CTX, tloc = row0 < NLAT ? (row0 & (SEQ - 1)) : ((row0 - NLAT) & (CTX - 1));
        const bool has_prev = tloc > 0, has_next = tloc + 16 < seqlen;
        float wg[3][8], wu[3][8], bg[8], bu[8];
#pragma unroll
        for (int k = 0; k < 3; ++k) { const f32x4 a = *(const f32x4*)(cw + k * F2 + col), b = *(const f32x4*)(cw + k * F2 + col + 4), c = *(const f32x4*)(cw + k * F2 + FH + col), d = *(const f32x4*)(cw + k * F2 + FH + col + 4);
            wg[k][0] = a.x; wg[k][1] = a.y; wg[k][2] = a.z; wg[k][3] = a.w; wg[k][4] = b.x; wg[k][5] = b.y; wg[k][6] = b.z; wg[k][7] = b.w;
            wu[k][0] = c.x; wu[k][1] = c.y; wu[k][2] = c.z; wu[k][3] = c.w; wu[k][4] = d.x; wu[k][5] = d.y; wu[k][6] = d.z; wu[k][7] = d.w; }
        { const f32x4 a = *(const f32x4*)(cb + col), b = *(const f32x4*)(cb + col + 4), c = *(const f32x4*)(cb + FH + col), d = *(const f32x4*)(cb + FH + col + 4);
            bg[0] = a.x; bg[1] = a.y; bg[2] = a.z; bg[3] = a.w; bg[4] = b.x; bg[5] = b.y; bg[6] = b.z; bg[7] = b.w; bu[0] = c.x; bu[1] = c.y; bu[2] = c.z; bu[3] = c.w; bu[4] = d.x; bu[5] = d.y; bu[6] = d.z; bu[7] = d.w; }
        const v4u zero4 = {0u, 0u, 0u, 0u};
        v4u gp = has_prev ? *(const GAS v4u*)(U + (size_t)(row0 - 1) * F2 + col) : zero4, up = has_prev ? *(const GAS v4u*)(U + (size_t)(row0 - 1) * F2 + FH + col) : zero4;
        v4u gc = *(const GAS v4u*)(U + (size_t)row0 * F2 + col), uc = *(const GAS v4u*)(U + (size_t)row0 * F2 + FH + col);
#pragma unroll 4
        for (int i = 0; i < 16; ++i) {
            const bool nx = (i < 15) || has_next;
            const v4u gn = nx ? *(const GAS v4u*)(U + (size_t)(row0 + i + 1) * F2 + col) : zero4, un = nx ? *(const GAS v4u*)(U + (size_t)(row0 + i + 1) * F2 + FH + col) : zero4;
            unsigned ow[4];
#pragma unroll
            for (int w = 0; w < 4; ++w) {
                const float g0 = wg[0][2 * w] * bflo(gp[w]) + wg[1][2 * w] * bflo(gc[w]) + wg[2][2 * w] * bflo(gn[w]) + bg[2 * w];
                const float g1 = wg[0][2 * w + 1] * bfhi(gp[w]) + wg[1][2 * w + 1] * bfhi(gc[w]) + wg[2][2 * w + 1] * bfhi(gn[w]) + bg[2 * w + 1];
                const float u0 = wu[0][2 * w] * bflo(up[w]) + wu[1][2 * w] * bflo(uc[w]) + wu[2][2 * w] * bflo(un[w]) + bu[2 * w];
                const float u1 = wu[0][2 * w + 1] * bfhi(up[w]) + wu[1][2 * w + 1] * bfhi(uc[w]) + wu[2][2 * w + 1] * bfhi(un[w]) + bu[2 * w + 1];
                ow[w] = pk2(silu_f(g0) * u0, silu_f(g1) * u1); }
            *(GAS v4u*)(A + (size_t)(row0 + i) * FH + col) = (v4u){ow[0], ow[1], ow[2], ow[3]};
            gp = gc; gc = gn; up = uc; uc = un;
        }
    }
}

struct EpiInProj {
    static constexpr bool PERM = false, AFTER_DRAIN = false;
    bf16* P; const float* gain; const float* rope;
    __device__ __forceinline__ void operator()(const pg8::f32x4 (&acc)[2][2][4][2], const pg8::Unit& u, int wr, int wc, int fr, int fq) const {
        const int pn = u.pn;
        int gidx = -1; float scale = 1.f;
        if (pn < 2) { gidx = 0; scale = QSCALE; } else if (pn < 4) { gidx = 1; } else if (pn < 6) { gidx = -1; } else if (pn < 8) { gidx = 2; scale = QSCALE; } else if (pn == 8) { gidx = (wc < 2) ? 3 : -1; }
        const int colbase = pn * 256 + wc * 64 + 4 * fq;
        const bool lat = u.pm < 64;
        if (gidx >= 0) {
            pg8::f32x4 g[2][2];
#pragma unroll
            for (int bj = 0; bj < 2; ++bj)
#pragma unroll
                for (int n = 0; n < 2; ++n) g[bj][n] = *(const pg8::f32x4*)(gain + gidx * 64 + 32 * bj + 16 * n + 4 * fq) * scale;
#pragma unroll
            for (int ai = 0; ai < 2; ++ai)
#pragma unroll
                for (int m = 0; m < 4; ++m) {
                    const int row = u.pm * 256 + ai * 128 + wr * 64 + m * 16 + fr;
                    float ss = 0.f;
#pragma unroll
                    for (int bj = 0; bj < 2; ++bj)
#pragma unroll
                        for (int n = 0; n < 2; ++n) { const pg8::f32x4 x = acc[ai][bj][m][n]; ss += (x[0] * x[0] + x[1] * x[1]) + (x[2] * x[2] + x[3] * x[3]); }
                    ss += __shfl_xor(ss, 16); ss += __shfl_xor(ss, 32);
                    const float rstd = 1.0f / sqrtf(ss * (1.f / 64.f) + RMS_EPS);
                    const int t = row & (SEQ - 1);
#pragma unroll
                    for (int bj = 0; bj < 2; ++bj) {
                        pg8::f32x4 x1 = acc[ai][bj][m][0] * rstd * g[bj][0], x2 = acc[ai][bj][m][1] * rstd * g[bj][1];
                        if (lat) { const int pos = bj ? (t & 63) : (t >> 6); const float* rp = rope + (pos * 16 + 4 * fq) * 2;
                            const pg8::f32x4 ra = *(const pg8::f32x4*)rp, rb = *(const pg8::f32x4*)(rp + 4);
                            const pg8::f32x4 c = {ra[0], ra[2], rb[0], rb[2]}, s = {ra[1], ra[3], rb[1], rb[3]};
                            const pg8::f32x4 o1 = x1 * c - x2 * s, o2 = x2 * c + x1 * s; x1 = o1; x2 = o2; }
                        bf16* dst = P + (size_t)row * PP + colbase + 32 * bj;
                        u32x2 w1; w1.x = pk2(x1[0], x1[1]); w1.y = pk2(x1[2], x1[3]); *(u32x2*)dst = w1;
                        u32x2 w2; w2.x = pk2(x2[0], x2[1]); w2.y = pk2(x2[2], x2[3]); *(u32x2*)(dst + 16) = w2;
                    }
                }
        } else {
#pragma unroll
            for (int ai = 0; ai < 2; ++ai)
#pragma unroll
                for (int m = 0; m < 4; ++m) {
                    const int row = u.pm * 256 + ai * 128 + wr * 64 + m * 16 + fr;
#pragma unroll
                    for (int bj = 0; bj < 2; ++bj)
#pragma unroll
                        for (int n = 0; n < 2; ++n) { const pg8::f32x4 x = acc[ai][bj][m][n]; u32x2 w; w.x = pk2(x[0], x[1]); w.y = pk2(x[2], x[3]);
                            *(u32x2*)(P + (size_t)row * PP + colbase + 32 * bj + 16 * n) = w; }
                }
        }
    }
};
struct EpiHyT {
    static constexpr bool PERM = false, AFTER_DRAIN = false;
    bf16* PT;
    __device__ __forceinline__ void operator()(const pg8::f32x4 (&acc)[2][2][4][2], const pg8::Unit& u, int wr, int wc, int fr, int fq) const {
#pragma unroll
        for (int bj = 0; bj < 2; ++bj)
#pragma unroll
            for (int n = 0; n < 2; ++n) { const int col = u.pn * 256 + wc * 64 + 32 * bj + 16 * n + fr;
#pragma unroll
                for (int ai = 0; ai < 2; ++ai)
#pragma unroll
                    for (int m = 0; m < 4; ++m) { const int row = u.pm * 256 + ai * 128 + wr * 64 + m * 16 + 4 * fq; const pg8::f32x4 x = acc[ai][bj][m][n];
                        u32x2 w; w.x = pk2(x[0], x[1]); w.y = pk2(x[2], x[3]); *(u32x2*)(PT + (size_t)col * MALL + row) = w; } }
    }
};
struct EpiRes {
    static constexpr bool PERM = false, AFTER_DRAIN = false;
    const float* xsrc; float* xlat; float* xctx; const float* gate;
    __device__ __forceinline__ void operator()(const pg8::f32x4 (&acc)[2][2][4][2], const pg8::Unit& u, int wr, int wc, int fr, int fq) const {
        const int r = u.pm < 32 ? 0 : u.pm < 64 ? 1 : 2;
        float* xb = u.pm < 64 ? xlat + (size_t)u.pm * 256 * DM : xctx + (size_t)(u.pm - 64) * 256 * DM;
        const float* xs = u.pm < 64 ? xsrc + (size_t)u.pm * 256 * DM : xb;
        const int col0 = u.pn * 256 + wc * 32 + 4 * fq;
        pg8::f32x4 gv[2][2];
#pragma unroll
        for (int bj = 0; bj < 2; ++bj)
#pragma unroll
            for (int n = 0; n < 2; ++n) gv[bj][n] = *(const pg8::f32x4*)(gate + r * 12288 + col0 + 128 * bj + 16 * n);
#pragma unroll
        for (int ai = 0; ai < 2; ++ai)
#pragma unroll
            for (int m = 0; m < 4; ++m) { const size_t ro = (size_t)(ai * 128 + wr * 64 + m * 16 + fr) * DM + col0;
#pragma unroll
                for (int bj = 0; bj < 2; ++bj)
#pragma unroll
                    for (int n = 0; n < 2; ++n) { const size_t o = ro + 128 * bj + 16 * n; *(pg8::f32x4*)(xb + o) = *(const pg8::f32x4*)(xs + o) + gv[bj][n] * acc[ai][bj][m][n]; } }
    }
};

struct SplitKOrder {
    int pm0, nN, S, KS, G, c;
    __device__ __forceinline__ bool next(int i, pg8::Unit& u) const { const int L = i * G + c; if (L >= 2 * nN * S) return false;
        const int ks = L % S, t = L / S; u.pn = t % nN; u.pm = pm0 + t / nN; u.koff = ks * KS; return true; }
    __device__ __forceinline__ void a_ready(const pg8::Unit&) const {}
    __device__ __forceinline__ void done(const pg8::Unit&) const {}
};
struct EpiResSlab {
    static constexpr bool PERM = false, AFTER_DRAIN = false;
    float* slab; const float* gate; int KS;
    __device__ __forceinline__ void operator()(const pg8::f32x4 (&acc)[2][2][4][2], const pg8::Unit& u, int wr, int wc, int fr, int fq) const {
        float* xb = slab + ((size_t)(u.koff / KS) * NCTXR + (size_t)(u.pm - 64) * 256) * DM;
        const int col0 = u.pn * 256 + wc * 32 + 4 * fq;
        pg8::f32x4 gv[2][2];
#pragma unroll
        for (int bj = 0; bj < 2; ++bj)
#pragma unroll
            for (int n = 0; n < 2; ++n) gv[bj][n] = *(const pg8::f32x4*)(gate + 2 * 12288 + col0 + 128 * bj + 16 * n);
#pragma unroll
        for (int ai = 0; ai < 2; ++ai)
#pragma unroll
            for (int m = 0; m < 4; ++m) { float* rp = xb + (size_t)(ai * 128 + wr * 64 + m * 16 + fr) * DM + col0;
#pragma unroll
                for (int bj = 0; bj < 2; ++bj)
#pragma unroll
                    for (int n = 0; n < 2; ++n) *(pg8::f32x4*)(rp + 128 * bj + 16 * n) = gv[bj][n] * acc[ai][bj][m][n]; }
    }
};

namespace att {
using bf16x8 = __attribute__((ext_vector_type(8))) short;
using s16x4 = __attribute__((ext_vector_type(4))) short;
using f32x16 = __attribute__((ext_vector_type(16))) float;
using u32x4 = __attribute__((ext_vector_type(4))) unsigned;
constexpr int KVBLK = 64, QBLK = 32;
constexpr float THR2 = 8.f;
constexpr float NEGBIG = -1e30f;
#define KSWZ64(row, colB) ((row) * 128 + ((colB) ^ ((((row) >> 1) & 7) << 4)))
#define ASBAR() __builtin_amdgcn_sched_barrier(0)
__device__ __forceinline__ int crow(int r, int hi) { return (r & 3) + 8 * (r >> 2) + 4 * hi; }
__device__ __forceinline__ unsigned cvtpk(float lo, float hi) { unsigned r; asm volatile("v_cvt_pk_bf16_f32 %0, %1, %2" : "=v"(r) : "v"(lo), "v"(hi)); return r; }
template <int DV> __device__ __forceinline__ int v_st(int k, int c) { const int kk = (k & ~0xC) | ((k & 4) << 1) | ((k & 8) >> 1); return ((kk >> 3) * (DV / 32) + (c >> 5)) * 512 + ((kk & 7) * 32 + (c & 31)) * 2; }
__device__ __forceinline__ int v_rd_base(int lane) { return ((lane & 3) << 3) | (((lane >> 2) & 3) << 6) | (((lane >> 4) & 1) << 5) | (((lane >> 5) & 1) << 8); }
template <int DV> constexpr int v_rd_off(int d0, int ks, int half) { return d0 * 512 + ks * (DV * 32) + half * (DV * 16); }
template <int OFF> __device__ __forceinline__ s16x4 tr_read(int vb) { s16x4 r; asm volatile("ds_read_b64_tr_b16 %0, %1 offset:%2" : "=&v"(r) : "v"(vb), "i"(OFF) : "memory"); return r; }

__device__ __forceinline__ void partialSM(f32x16& p0, f32x16& p1, float& m_reg, float& mn, float& alpha) {
    float pmax = p0[0];
#pragma unroll
    for (int r = 1; r < 16; ++r) pmax = fmaxf(pmax, p0[r]);
#pragma unroll
    for (int r = 0; r < 16; ++r) pmax = fmaxf(pmax, p1[r]);
    { auto rr = __builtin_amdgcn_permlane32_swap(__float_as_uint(pmax), __float_as_uint(pmax), false, false); pmax = fmaxf(__uint_as_float(rr[0]), __uint_as_float(rr[1])); }
    if (__builtin_expect(__all(pmax - m_reg <= THR2), 1)) { mn = m_reg; alpha = 1.f; }
    else { mn = fmaxf(m_reg, pmax); alpha = __builtin_amdgcn_exp2f(m_reg - mn); m_reg = mn; }
#pragma unroll
    for (int r = 0; r < 16; ++r) p0[r] = __builtin_amdgcn_exp2f(p0[r] - mn);
#pragma unroll
    for (int r = 0; r < 16; ++r) p1[r] = p1[r] - mn;
}
__device__ __forceinline__ void finishSM(f32x16& p0, f32x16& p1, float alpha, float& l_reg, bf16x8& pa0, bf16x8& pa1, bf16x8& pa2, bf16x8& pa3) {
#pragma unroll
    for (int r = 0; r < 16; ++r) p1[r] = __builtin_amdgcn_exp2f(p1[r]);
    float ps = 0;
#pragma unroll
    for (int r = 0; r < 16; ++r) ps += p0[r];
#pragma unroll
    for (int r = 0; r < 16; ++r) ps += p1[r];
    { auto rr = __builtin_amdgcn_permlane32_swap(__float_as_uint(ps), __float_as_uint(ps), false, false); ps = __uint_as_float(rr[0]) + __uint_as_float(rr[1]); }
    l_reg = l_reg * alpha + ps;
#define PK4(P, BASE, OUT) do { unsigned a0 = cvtpk(P[BASE + 0], P[BASE + 1]), a1 = cvtpk(P[BASE + 2], P[BASE + 3]);   \
    unsigned b0 = cvtpk(P[BASE + 4], P[BASE + 5]), b1 = cvtpk(P[BASE + 6], P[BASE + 7]);                              \
    auto r0 = __builtin_amdgcn_permlane32_swap(a0, b0, false, false); auto r1 = __builtin_amdgcn_permlane32_swap(a1, b1, false, false); \
    u32x4 w = {r0[0], r1[0], r0[1], r1[1]}; OUT = *reinterpret_cast<bf16x8*>(&w); } while (0)
    PK4(p0, 0, pa0); PK4(p0, 8, pa1); PK4(p1, 0, pa2); PK4(p1, 8, pa3);
#undef PK4
}
__device__ __forceinline__ void qkt(f32x16& p0, f32x16& p1, const char* Ks, const bf16x8* qr, int r32, int hi) {
    p0 = f32x16{}; p1 = f32x16{};
#pragma unroll
    for (int d0 = 0; d0 < 4; ++d0) { const int cb = (d0 * 16 + hi * 8) * 2;
        const bf16x8 b0 = *reinterpret_cast<const bf16x8*>(Ks + KSWZ64(r32, cb));
        const bf16x8 b1 = *reinterpret_cast<const bf16x8*>(Ks + KSWZ64(32 + r32, cb));
        p0 = __builtin_amdgcn_mfma_f32_32x32x16_bf16(b0, qr[d0], p0, 0, 0, 0);
        p1 = __builtin_amdgcn_mfma_f32_32x32x16_bf16(b1, qr[d0], p1, 0, 0, 0); }
}
template <int DV, int D0> __device__ __forceinline__ void pv_one(f32x16& od, int vb, bf16x8 pa0, bf16x8 pa1, bf16x8 pa2, bf16x8 pa3) {
    const s16x4 l0 = tr_read<v_rd_off<DV>(D0, 0, 0)>(vb), h0 = tr_read<v_rd_off<DV>(D0, 0, 1)>(vb), l1 = tr_read<v_rd_off<DV>(D0, 1, 0)>(vb), h1 = tr_read<v_rd_off<DV>(D0, 1, 1)>(vb);
    const s16x4 l2 = tr_read<v_rd_off<DV>(D0, 2, 0)>(vb), h2 = tr_read<v_rd_off<DV>(D0, 2, 1)>(vb), l3 = tr_read<v_rd_off<DV>(D0, 3, 0)>(vb), h3 = tr_read<v_rd_off<DV>(D0, 3, 1)>(vb);
    asm volatile("s_waitcnt lgkmcnt(0)" ::: "memory"); ASBAR();
#define PK(L, H) (bf16x8){L[0], L[1], L[2], L[3], H[0], H[1], H[2], H[3]}
    od = __builtin_amdgcn_mfma_f32_32x32x16_bf16(pa0, PK(l0, h0), od, 0, 0, 0);
    od = __builtin_amdgcn_mfma_f32_32x32x16_bf16(pa1, PK(l1, h1), od, 0, 0, 0);
    od = __builtin_amdgcn_mfma_f32_32x32x16_bf16(pa2, PK(l2, h2), od, 0, 0, 0);
    od = __builtin_amdgcn_mfma_f32_32x32x16_bf16(pa3, PK(l3, h3), od, 0, 0, 0);
#undef PK
}
template <int DV> __device__ __forceinline__ void pv_all(f32x16* o, int vb, bf16x8 pa0, bf16x8 pa1, bf16x8 pa2, bf16x8 pa3) {
    pv_one<DV, 0>(o[0], vb, pa0, pa1, pa2, pa3); pv_one<DV, 1>(o[1], vb, pa0, pa1, pa2, pa3);
    if constexpr (DV == 128) { pv_one<DV, 2>(o[2], vb, pa0, pa1, pa2, pa3); pv_one<DV, 3>(o[3], vb, pa0, pa1, pa2, pa3); }
}
struct KeyMap { const bf16* kc; const bf16* vc; const bf16* kl; const bf16* vl; int q0m128; int band; };
template <bool BAND> __device__ __forceinline__ void key_ptrs(const KeyMap& km, int t, int i, const bf16*& kp, const bf16*& vp) {
    if (t < 4) { const size_t o = (size_t)(64 * t + i) * PP; kp = km.kc + o; vp = km.vc + o; }
    else { int kpos = 64 * (t - 4) + i; if (BAND && km.band) { kpos += km.q0m128; kpos = kpos < 0 ? 0 : (kpos > SEQ - 1 ? SEQ - 1 : kpos); } const size_t o = (size_t)kpos * PP; kp = km.kl + o; vp = km.vl + o; }
}
__device__ __forceinline__ void band_mask(f32x16& p0, f32x16& p1, const KeyMap& km, int t, int qpos, int hi) {
    if (km.band && t >= 4) { const int kb = km.q0m128 + 64 * (t - 4);
#pragma unroll
        for (int r = 0; r < 16; ++r) { const int k0 = kb + crow(r, hi), k1 = k0 + 32; const int d0 = k0 - qpos, d1 = k1 - qpos;
            const bool v0 = (k0 >= 0) && (k0 < SEQ) && (d0 <= 128) && (d0 >= -128), v1 = (k1 >= 0) && (k1 < SEQ) && (d1 <= 128) && (d1 >= -128);
            p0[r] = v0 ? p0[r] : NEGBIG; p1[r] = v1 ? p1[r] : NEGBIG; } }
}
template <int DV> constexpr int shm_bytes() { return 2 * 8192 + 2 * 64 * DV * 2 + NWAVES * 256; }
template <int DV, bool BAND, int SD>
__device__ __forceinline__ void attn_pass(const bf16* __restrict__ Qb, const KeyMap km, int NT, int q0, f32x16 (&o)[DV / 32], float& l_out, float& m_out, char* lds) {
    constexpr int SHM_K = 8192, SHM_V = 64 * DV * 2, NV = DV / 64;
    int tid_ = threadIdx.x; asm volatile("" : "+v"(tid_));
    const int tid = tid_, wid = tid >> 6, lane = tid & 63, r32 = lane & 31, hi = lane >> 5;
    char* V_lds = lds; char* K_lds = lds + 2 * SHM_V;
    float* wsf = (float*)(lds + WSF_OFF) + wid * 64; float* al_l = wsf + 32;
    float m_reg = NEGBIG, l_reg = 0.f; bf16x8 qr[4];
#pragma unroll
    for (int d = 0; d < DV / 32; ++d) o[d] = f32x16{};
    const bf16* Qw = Qb + (size_t)(wid * QBLK + r32) * PP + hi * 8;
#pragma unroll
    for (int d0 = 0; d0 < 4; ++d0) qr[d0] = *reinterpret_cast<const bf16x8*>(Qw + d0 * 16);
    const int kr = tid >> 3, kc8 = (tid & 7) * 8;
    const int sr = tid >> 4, sc = (tid & 15) * 8;
    const int kst = KSWZ64(kr, kc8 * 2);
    const int vst0 = (DV == 128) ? v_st<DV>(sr, sc) : v_st<DV>(kr, kc8), vst1 = (DV == 128) ? v_st<DV>(32 + sr, sc) : 0;
    const int vb0 = (int)(uintptr_t)V_lds + v_rd_base(lane);
    const int qpos = q0 + wid * QBLK + r32;
    struct { bf16x8 k, v0, v1; } st[SD];
    constexpr int SO = SD - 1;
#define SLOAD(i, t) do { const bf16 *kp_, *vp_; key_ptrs<BAND>(km, (t), kr, kp_, vp_); st[i].k = *reinterpret_cast<const bf16x8*>(kp_ + kc8); \
        if constexpr (NV == 1) { st[i].v0 = *reinterpret_cast<const bf16x8*>(vp_ + kc8); } \
        else { key_ptrs<BAND>(km, (t), sr, kp_, vp_); st[i].v0 = *reinterpret_cast<const bf16x8*>(vp_ + sc); key_ptrs<BAND>(km, (t), 32 + sr, kp_, vp_); st[i].v1 = *reinterpret_cast<const bf16x8*>(vp_ + sc); } } while (0)
#define SWRITE(b, i) do { *(bf16x8*)(K_lds + (b) * SHM_K + kst) = st[i].k; *(bf16x8*)(V_lds + (b) * SHM_V + vst0) = st[i].v0; \
        if constexpr (NV == 2) { *(bf16x8*)(V_lds + (b) * SHM_V + vst1) = st[i].v1; } } while (0)
#define SWAIT() do { if constexpr (SD == 1) asm volatile("s_waitcnt vmcnt(0)" ::: "memory"); else if constexpr (NV == 2) asm volatile("s_waitcnt vmcnt(3)" ::: "memory"); else asm volatile("s_waitcnt vmcnt(2)" ::: "memory"); } while (0)
#define RESC(a) do { if (__any((a) < 1.f)) { if (hi == 0) al_l[r32] = (a); asm volatile("s_waitcnt lgkmcnt(0)" ::: "memory"); \
        _Pragma("unroll") for (int d = 0; d < DV / 32; ++d) _Pragma("unroll") for (int r = 0; r < 16; ++r) o[d][r] *= al_l[crow(r, hi)]; } } while (0)
    f32x16 pA0, pA1, pB0, pB1; float mnA, mnB, alA, alB; bf16x8 pa0, pa1, pa2, pa3;
    SLOAD(0, 0); asm volatile("s_waitcnt vmcnt(0)" ::: "memory"); SWRITE(0, 0); __syncthreads();
    qkt(pA0, pA1, K_lds, qr, r32, hi); if constexpr (BAND) band_mask(pA0, pA1, km, 0, qpos, hi); partialSM(pA0, pA1, m_reg, mnA, alA);
    SLOAD(SO, 1); if constexpr (SD == 2) { if (2 < NT) SLOAD(0, 2); }
    SWAIT(); SWRITE(1, SO); __syncthreads();
    for (int j = 1; j + 1 < NT; j += 2) {
        ASBAR(); qkt(pB0, pB1, K_lds + SHM_K, qr, r32, hi); if constexpr (BAND) band_mask(pB0, pB1, km, j, qpos, hi);
        finishSM(pA0, pA1, alA, l_reg, pa0, pa1, pa2, pa3); ASBAR();
        SLOAD(SO, j + SD); ASBAR();
        pv_all<DV>(o, vb0, pa0, pa1, pa2, pa3); partialSM(pB0, pB1, m_reg, mnB, alB);
        __syncthreads(); SWAIT(); SWRITE(0, 0);
        RESC(alB); __syncthreads();
        ASBAR(); qkt(pA0, pA1, K_lds, qr, r32, hi); if constexpr (BAND) band_mask(pA0, pA1, km, j + 1, qpos, hi);
        finishSM(pB0, pB1, alB, l_reg, pa0, pa1, pa2, pa3); ASBAR();
        if (SD == 1 || j + 3 < NT) SLOAD(0, j + 1 + SD); ASBAR();
        pv_all<DV>(o, vb0 + SHM_V, pa0, pa1, pa2, pa3); partialSM(pA0, pA1, m_reg, mnA, alA);
        __syncthreads(); SWAIT(); SWRITE(1, SO);
        RESC(alA); __syncthreads();
    }
    ASBAR(); qkt(pB0, pB1, K_lds + SHM_K, qr, r32, hi); if constexpr (BAND) band_mask(pB0, pB1, km, NT - 1, qpos, hi);
    finishSM(pA0, pA1, alA, l_reg, pa0, pa1, pa2, pa3); ASBAR();
    pv_all<DV>(o, vb0, pa0, pa1, pa2, pa3); partialSM(pB0, pB1, m_reg, mnB, alB);
    __syncthreads(); RESC(alB);
    finishSM(pB0, pB1, alB, l_reg, pa0, pa1, pa2, pa3); ASBAR();
    pv_all<DV>(o, vb0 + SHM_V, pa0, pa1, pa2, pa3);
    l_out = l_reg; m_out = m_reg;
    __syncthreads();
#undef SLOAD
#undef SWRITE
#undef SWAIT
#undef RESC
}
template <int DV> __device__ __forceinline__ void stage_o(const f32x16 (&o)[DV / 32], float* stg, int r32, int hi) {
    float* b = stg + 4 * hi * DV + r32;
#pragma unroll
    for (int d0 = 0; d0 < DV / 32; ++d0)
#pragma unroll
        for (int r = 0; r < 16; ++r) b[((r & 3) + 8 * (r >> 2)) * DV + 32 * d0] = o[d0][r];
}
#undef KSWZ64
#undef ASBAR
}

constexpr size_t WS_ASCR_CTX = 1133 * MiB;
__device__ __forceinline__ void attnA_unit(Frame& F, int l, int b, int h, int qb, int stash_slot) {
    const bf16* P = WSP(bf16, WS_P); bf16* MIX = WSP(bf16, WS_MIX);
    const int lane = F.lane, r32 = lane & 31, hi = lane >> 5, wid = F.wave;
    const size_t crow0 = (size_t)NLAT + (size_t)b * CTX, lrow0 = (size_t)b * SEQ;
    const size_t qrow0 = qb < 0 ? crow0 : lrow0 + (size_t)qb * 256;
    const int NT = qb < 0 ? 4 : 4 + SEQ / 64;
    float* wsf = (float*)(F.ldsg + WSF_OFF) + wid * 64; float* stg = (float*)(F.ldsg + wid * 16384);
    f32x4* scr = (qb < 0 ? WSP(f32x4, WS_ASCR_CTX) : WSP(f32x4, WS_ASCR)) + ((size_t)stash_slot * 512 + F.tid) * 16;
    const int row = lane >> 1, half = lane & 1;
#pragma unroll 1
    for (int comp = 0; comp < 2; ++comp) {
        att::f32x16 o[4]; float l_, m_;
        const att::KeyMap km{P + crow0 * PP + OFF_KA + h * 128 + comp * 64, P + crow0 * PP + OFF_VA + h * 128, P + lrow0 * PP + OFF_KA + h * 128 + comp * 64, P + lrow0 * PP + OFF_VA + h * 128, 0, 0};
        att::attn_pass<128, false, 1>(P + qrow0 * PP + OFF_QA + h * 128 + comp * 64, km, NT, 0, o, l_, m_, F.ldsg);
        att::stage_o<128>(o, stg, r32, hi);
        if (hi == 0) wsf[r32] = l_;
        asm volatile("s_waitcnt lgkmcnt(0)" ::: "memory");
        const float rl = 1.0f / wsf[row];
        const f32x4* sp = (const f32x4*)(stg + row * 128 + half * 64);
        if (comp == 0) {
#pragma unroll
            for (int j = 0; j < 16; ++j) scr[j] = sp[j] * rl;
        } else {
            const float lam = WSP(float, WS_LAMB)[l];
            f32x4 f[16]; float ss = 0.f;
#pragma unroll
            for (int j = 0; j < 16; ++j) { f[j] = scr[j] - (sp[j] * rl) * lam; ss += (f[j].x * f[j].x + f[j].y * f[j].y) + (f[j].z * f[j].z + f[j].w * f[j].w); }
            ss += __shfl_xor(ss, 1);
            const float rstd = (1.0f / sqrtf(ss * (1.f / 128.f) + RMS_EPS)) * (1.0f - (0.8f - 0.6f * __expf(-0.3f * (float)l)));
            const f32x4* gp = (const f32x4*)(F.a->in[I_SUBLN] + l * 128 + half * 64);
            v4u* dst = (v4u*)(MIX + (qrow0 + wid * 32 + row) * DM + h * 128 + half * 64);
#pragma unroll
            for (int j = 0; j < 8; ++j) { const f32x4 a = f[2 * j] * gp[2 * j] * rstd, c = f[2 * j + 1] * gp[2 * j + 1] * rstd;
                dst[j] = (v4u){pk2(a.x, a.y), pk2(a.z, a.w), pk2(c.x, c.y), pk2(c.z, c.w)}; }
        }
        asm volatile("s_waitcnt lgkmcnt(0)" ::: "memory"); __syncthreads();
    }
}
__device__ __forceinline__ void attnB_unit(Frame& F, int l, int b, int hq, int qb) {
    const bf16* P = WSP(bf16, WS_P); bf16* MIX = WSP(bf16, WS_MIX);
    const int lane = F.lane, r32 = lane & 31, hi = lane >> 5, wid = F.wave, kvh = hq >> 2;
    const size_t crow0 = (size_t)NLAT + (size_t)b * CTX, lrow0 = (size_t)b * SEQ;
    const size_t qrow0 = qb < 0 ? crow0 : lrow0 + (size_t)qb * 256;
    const int NT = qb < 0 ? 4 : 12;
    float* wsf = (float*)(F.ldsg + WSF_OFF) + wid * 64; float* stg = (float*)(F.ldsg + wid * 8192);
    const att::KeyMap km{P + crow0 * PP + OFF_KB + kvh * 64, P + crow0 * PP + OFF_VB + kvh * 64, P + lrow0 * PP + OFF_KB + kvh * 64, P + lrow0 * PP + OFF_VB + kvh * 64, qb * 256 - 128, qb >= 0 ? 1 : 0};
    att::f32x16 o[2]; float l_, m_;
    att::attn_pass<64, true, 2>(P + qrow0 * PP + OFF_QB + hq * 64, km, NT, qb < 0 ? 0 : qb * 256, o, l_, m_, F.ldsg);
    l_ += __builtin_amdgcn_exp2f(F.a->in[I_SINK][l * 8 + hq] * 1.4426950408889634f - m_);
    att::stage_o<64>(o, stg, r32, hi);
    if (hi == 0) wsf[r32] = l_;
    asm volatile("s_waitcnt lgkmcnt(0)" ::: "memory");
    const int row = lane >> 1, half = lane & 1;
    const float rl = 1.0f / wsf[row];
    const f32x4* sp = (const f32x4*)(stg + row * 64 + half * 32);
    v4u* dst = (v4u*)(MIX + (qrow0 + wid * 32 + row) * DM + 512 + hq * 64 + half * 32);
#pragma unroll
    for (int j = 0; j < 4; ++j) { const f32x4 a = sp[2 * j] * rl, c = sp[2 * j + 1] * rl; dst[j] = (v4u){pk2(a.x, a.y), pk2(a.z, a.w), pk2(c.x, c.y), pk2(c.z, c.w)}; }
    asm volatile("s_waitcnt lgkmcnt(0)" ::: "memory"); __syncthreads();
}
constexpr int POOL_W_OFF = 0, POOL_U_OFF = 65536, POOL_D_OFF = 65536 + 20480;
__device__ __forceinline__ void pool_load_w(Frame& F, int l, int g) {
    float* Wl = (float*)(F.ldsg + POOL_W_OFF); const GAS f32x4* W = (const GAS f32x4*)(F.a->in[I_POOLW] + ((size_t)(l * 4 + g) * 128) * 128);
#pragma unroll
    for (int k = 0; k < 8; ++k) ((f32x4*)Wl)[F.tid + 512 * k] = W[F.tid + 512 * k];
    __syncthreads();
}
__device__ __forceinline__ void pool_unit(Frame& F, int l, int s, int ck, int g) {
    const bf16* P = WSP(bf16, WS_P); bf16* MIX = WSP(bf16, WS_MIX);
    const float* Wl = (const float*)(F.ldsg + POOL_W_OFF); bf16* ub = (bf16*)(F.ldsg + POOL_U_OFF); float* dl = (float*)(F.ldsg + POOL_D_OFF);
    const int Ls = s < 2 ? SEQ : CTX; const size_t rowbase = s < 2 ? (size_t)s * SEQ : (size_t)NLAT + (size_t)(s - 2) * CTX; const int t0 = ck * 64;
    for (int ch = F.tid; ch < 80 * 16; ch += 512) { const int row = ch >> 4, c8 = (ch & 15) * 8, t = t0 - 8 + row;
        v4u w = {0u, 0u, 0u, 0u}; if (t >= 0 && t < Ls) w = *(const GAS v4u*)(P + (rowbase + t) * PP + OFF_POOL + g * 128 + c8);
        *(v4u*)(ub + row * 128 + c8) = w; }
    __syncthreads();
    const int c = F.tid & 127, tq = F.tid >> 7, wdw = 2 << g, lo = wdw >> 1;
    for (int tt = 0; tt < 16; ++tt) { const int t = tq * 16 + tt, T = t0 + t; int st = T - lo, en = T + wdw - lo; st = st < 0 ? 0 : st; en = en > Ls ? Ls : en;
        float sum = 0.f; for (int ti = st; ti < en; ++ti) sum += bf2f(ub[(ti - t0 + 8) * 128 + c]);
        dl[t * 132 + c] = sum / (float)(en - st) - bf2f(ub[(t + 8) * 128 + c]); }
    __syncthreads();
    float acc[16];
#pragma unroll
    for (int tt = 0; tt < 16; ++tt) acc[tt] = 0.f;
#pragma unroll 2
    for (int k4 = 0; k4 < 32; ++k4) { const float w0 = Wl[(4 * k4) * 128 + c], w1 = Wl[(4 * k4 + 1) * 128 + c], w2 = Wl[(4 * k4 + 2) * 128 + c], w3 = Wl[(4 * k4 + 3) * 128 + c];
#pragma unroll
        for (int tt = 0; tt < 16; ++tt) { const f32x4 d = *(const f32x4*)(dl + (tq * 16 + tt) * 132 + 4 * k4); acc[tt] += d.x * w0 + d.y * w1 + d.z * w2 + d.w * w3; } }
    const float ls = F.a->in[I_POOLS][l * 512 + g * 128 + c];
#pragma unroll
    for (int tt = 0; tt < 16; ++tt) MIX[(rowbase + t0 + tq * 16 + tt) * DM + 1024 + g * 128 + c] = (bf16)f2bf(acc[tt] * ls);
    __syncthreads();
}
__device__ __forceinline__ void hyena_ctx_unit(Frame& F, int l, int b, int ch) {
    const bf16* PT = WSP(bf16, WS_PT); bf16* MIX = WSP(bf16, WS_MIX);
    float* zs = (float*)(F.ldsg + F.wave * 4096); float* kc = zs + 256;
    const float* cw = F.a->in[I_HCW] + (size_t)l * 3 * HYC; const float* cb = F.a->in[I_HCB] + (size_t)l * HYC;
    const size_t tb = (size_t)NLAT + (size_t)b * CTX;
    const bf16* pv = PT + (size_t)ch * MALL + tb; const bf16* p1 = PT + (size_t)(512 + ch) * MALL + tb; const bf16* p2 = PT + (size_t)(1024 + ch) * MALL + tb;
    float zr[4], x2r[4];
#pragma unroll
    for (int i = 0; i < 4; ++i) { const int s = F.lane + 64 * i; const bool hp = s > 0, hn = s < CTX - 1;
        const float v = cw[ch] * (hp ? bf2f(pv[s - 1]) : 0.f) + cw[HYC + ch] * bf2f(pv[s]) + cw[2 * HYC + ch] * (hn ? bf2f(pv[s + 1]) : 0.f) + cb[ch];
        const float x1 = cw[512 + ch] * (hp ? bf2f(p1[s - 1]) : 0.f) + cw[HYC + 512 + ch] * bf2f(p1[s]) + cw[2 * HYC + 512 + ch] * (hn ? bf2f(p1[s + 1]) : 0.f) + cb[512 + ch];
        x2r[i] = cw[1024 + ch] * (hp ? bf2f(p2[s - 1]) : 0.f) + cw[HYC + 1024 + ch] * bf2f(p2[s]) + cw[2 * HYC + 1024 + ch] * (hn ? bf2f(p2[s + 1]) : 0.f) + cb[1024 + ch];
        zr[i] = v * x1; zs[s] = zr[i]; }
    const float* kcg = WSP(float, WS_KC) + ((size_t)l * 512 + ch) * 512;
#pragma unroll
    for (int i = 0; i < 8; ++i) kc[F.lane + 64 * i] = kcg[F.lane + 64 * i];
    asm volatile("s_waitcnt lgkmcnt(0)" ::: "memory");
    float y[4] = {0.f, 0.f, 0.f, 0.f};
    for (int s = 0; s < CTX; ++s) { const float z = zs[s];
#pragma unroll
        for (int i = 0; i < 4; ++i) y[i] += kc[(F.lane + 64 * i - s) & 511] * z; }
    const float bias = F.a->in[I_HBIAS][l * 512 + ch];
#pragma unroll
    for (int i = 0; i < 4; ++i) MIX[(tb + F.lane + 64 * i) * DM + 1536 + ch] = (bf16)f2bf(x2r[i] * (y[i] + bias * zr[i]));
    asm volatile("s_waitcnt lgkmcnt(0)" ::: "memory");
}
__device__ __forceinline__ void hy_load8(const bf16* p, int t0, float (&x)[10]) {
    const v4u w = *(const GAS v4u*)(p + t0);
    x[1] = bflo(w.x); x[2] = bfhi(w.x); x[3] = bflo(w.y); x[4] = bfhi(w.y); x[5] = bflo(w.z); x[6] = bfhi(w.z); x[7] = bflo(w.w); x[8] = bfhi(w.w);
    x[0] = t0 > 0 ? bf2f(p[t0 - 1]) : 0.f; x[9] = t0 + 8 < SEQ ? bf2f(p[t0 + 8]) : 0.f;
}
__device__ __forceinline__ void hyena_lat_unit(Frame& F, int l, int ch) {
    const bf16* PT = WSP(bf16, WS_PT); bf16* MIX = WSP(bf16, WS_MIX);
    f32x2* X = (f32x2*)F.ldsg; float* Xf = (float*)F.ldsg;
    const float* cw = F.a->in[I_HCW] + (size_t)l * 3 * HYC; const float* cb = F.a->in[I_HCB] + (size_t)l * HYC;
    const float wv0 = cw[ch], wv1 = cw[HYC + ch], wv2 = cw[2 * HYC + ch], bv = cb[ch];
    const float wa0 = cw[512 + ch], wa1 = cw[HYC + 512 + ch], wa2 = cw[2 * HYC + 512 + ch], ba = cb[512 + ch];
    const float wb0 = cw[1024 + ch], wb1 = cw[HYC + 1024 + ch], wb2 = cw[2 * HYC + 1024 + ch], bb = cb[1024 + ch];
#pragma unroll 1
    for (int it = F.tid; it < 2048; it += 512) { const int b = it >> 10, t0 = (it & 1023) * 8; const size_t tb = (size_t)b * SEQ;
        float xv[10], xa[10]; hy_load8(PT + (size_t)ch * MALL + tb, t0, xv); hy_load8(PT + (size_t)(512 + ch) * MALL + tb, t0, xa);
#pragma unroll
        for (int i = 0; i < 8; ++i) { const float v = wv0 * xv[i] + wv1 * xv[i + 1] + wv2 * xv[i + 2] + bv, a = wa0 * xa[i] + wa1 * xa[i + 1] + wa2 * xa[i + 2] + ba; Xf[2 * (t0 + i) + b] = v * a; } }
#pragma unroll
    for (int k = 0; k < 16; ++k) X[SEQ + F.tid + 512 * k] = (f32x2){0.f, 0.f};
    __syncthreads();
#pragma unroll 1
    for (int s = 0; s < 7; ++s) { fft_stage_fwd<512>(X, s, F.tid); __syncthreads(); }
    const f32x2* kf = WSP(f32x2, WS_KF) + ((size_t)l * 512 + ch) * NFFT;
#pragma unroll 8
    for (int k = 0; k < 32; ++k) { const int i = F.tid + 512 * k; const f32x2 a = X[i], w = kf[i]; X[i] = (f32x2){a.x * w.x - a.y * w.y, a.x * w.y + a.y * w.x}; }
    __syncthreads();
#pragma unroll 1
    for (int s = 6; s >= 0; --s) { fft_stage_inv<512>(X, s, F.tid); __syncthreads(); }
    const float bias = F.a->in[I_HBIAS][l * 512 + ch];
#pragma unroll 1
    for (int it = F.tid; it < 2048; it += 512) { const int b = it >> 10, t0 = (it & 1023) * 8; const size_t tb = (size_t)b * SEQ;
        float xv[10], xa[10], xb[10]; hy_load8(PT + (size_t)ch * MALL + tb, t0, xv); hy_load8(PT + (size_t)(512 + ch) * MALL + tb, t0, xa); hy_load8(PT + (size_t)(1024 + ch) * MALL + tb, t0, xb);
#pragma unroll
        for (int i = 0; i < 8; ++i) { const float v = wv0 * xv[i] + wv1 * xv[i + 1] + wv2 * xv[i + 2] + bv, a = wa0 * xa[i] + wa1 * xa[i + 1] + wa2 * xa[i + 2] + ba, x2 = wb0 * xb[i] + wb1 * xb[i + 1] + wb2 * xb[i + 2] + bb;
            const float z = v * a, y = Xf[2 * (t0 + i) + b];
            MIX[(tb + t0 + i) * DM + 1536 + ch] = (bf16)f2bf(x2 * (y + bias * z)); } }
    __syncthreads();
}

#ifndef MK_GSP2
#define MK_GSP2 true
#endif
#ifndef MK_GALIGN
#define MK_GALIGN true
#endif
__global__ void __launch_bounds__(NWAVES * 64, 2) fwd_kernel(Args args) {
    extern __shared__ __attribute__((aligned(16))) unsigned char lds[];
    Frame F;
    F.lds = (LAS unsigned char*)lds; F.ldsg = (char*)lds;
    F.MISC = (volatile LAS unsigned*)(F.lds + MISC_OFF);
    F.tid = threadIdx.x; F.lane = F.tid & 63; F.wave = __builtin_amdgcn_readfirstlane(F.tid >> 6);
    F.G = gridDim.x; { const int bx = blockIdx.x; F.vcu = (F.G % 8 == 0) ? (bx % 8) * (F.G / 8) + bx / 8 : bx; }
    F.gw = F.vcu * NWAVES + F.wave; F.NGW = F.G * NWAVES;
    F.a = (const Args __attribute__((address_space(4)))*)__builtin_amdgcn_kernarg_segment_ptr();
    F.ctl = (gu32*)(args.ws + WS_CTL);
    for (int u = F.tid; u < (LDS_BYTES - SCR_OFF) / 4; u += NWAVES * 64) ((LAS unsigned*)(F.lds + SCR_OFF))[u] = 0u;
    __syncthreads();
    XcdBarrier bar = xcd_barrier_post((unsigned*)(F.ctl + CW_BAR), F.MISC + 8);
    const int bid = blockIdx.x, G = F.G;
#ifndef MK_BARREP
#define MK_BARREP 1
#endif
#define GRID_BAR() do { for (int br_ = 0; br_ < MK_BARREP; ++br_) { XcdBarrier bl_ = bar; asm volatile("" : "+s"(bl_.bar), "+s"(bl_.x)); xcd_barrier(bl_); } } while (0)

#ifndef MK_PH
#define MK_PH 0xFFFF
#endif
#ifndef MK_REP
#define MK_REP 0
#endif
#define PH(k) F.tid = threadIdx.x; asm volatile("" : "+v"(F.tid), "+s"(F.a) :: "memory"); F.lane = F.tid & 63; for (int rep_ = 0; rep_ < ((((MK_REP) >> (k)) & 1) ? 2 : 1); ++rep_) if ((MK_PH >> (k)) & 1)
    PH(0) prologue_a(F); GRID_BAR();
    PH(1) prologue_b(F); GRID_BAR();
    PH(2) prologue_c(F); GRID_BAR();

#pragma unroll 1
    for (int l = 0; l < DEPTH; ++l) {
        const bool last = (l == DEPTH - 1);
        const int MR = last ? NLAT : MALL;
        const float* mod = WSP(float, WS_MOD) + (size_t)l * 3 * 12288;
        PH(3) norm_phase(F, l, 0, MALL, l > 0 ? 11 : 0, l == 0 ? F.a->in[I_X] : F.a->out); GRID_BAR();
        PH(4) { pg8::Gemm g{WSP(bf16, WS_H), WSP(bf16, WS_WIN) + (size_t)l * INC * DM, MALL, PP, DM, DM}; pg8::StaticOrder S; S.init(MALL, PP, G, bid);
          EpiInProj E{WSP(bf16, WS_P), F.a->in[I_QKG] + l * 256, WSP(float, WS_ROPE)};
          pg8::gemm_phase<EpiInProj, pg8::StaticOrder, MK_GALIGN, MK_GSP2, false>(F.lds, g, S, E); }
        PH(5) { pg8::Gemm g{WSP(bf16, WS_H), WSP(bf16, WS_WIN) + (size_t)l * INC * DM + (size_t)PP * DM, MALL, HYC, DM, DM}; pg8::StaticOrder S; S.init(MALL, HYC, G, bid);
          EpiHyT E{WSP(bf16, WS_PT)};
          pg8::gemm_phase<EpiHyT, pg8::StaticOrder, MK_GALIGN, MK_GSP2, true>(F.lds, g, S, E); }
        GRID_BAR();
        PH(6) for (int i = F.vcu; i < 256; i += G) attnA_unit(F, l, i >> 7, (i >> 5) & 3, i & 31, i);
        PH(7) for (int i = F.vcu; i < 512; i += G) attnB_unit(F, l, i >> 8, (i >> 5) & 7, i & 31);
        PH(8) for (int i = F.vcu; i < 512; i += G) hyena_lat_unit(F, l, i);
        PH(9) { const int npool = last ? 1024 : 1056;
          int gl = -1;
          for (int i = bid; i < npool; i += G) { const int g = i & 3, c = i >> 2; if (g != gl) { pool_load_w(F, l, g); gl = g; }
              if (c < 256) pool_unit(F, l, c >> 7, c & 127, g); else pool_unit(F, l, 2 + ((c - 256) >> 2), (c - 256) & 3, g); } }
        PH(10) if (!last) {
            for (int i = bid; i < 8; i += G) attnA_unit(F, l, i >> 2, i & 3, -1, i);
            for (int i = bid - 8; i >= 0 && i < 16; i += G) attnB_unit(F, l, i >> 3, i & 7, -1);
            for (int i = F.gw; i < 1024; i += F.NGW) hyena_ctx_unit(F, l, i >> 9, i & 511);
            __syncthreads();
        }
        GRID_BAR();
        PH(11) { { pg8::Gemm g{WSP(bf16, WS_MIX), WSP(bf16, WS_WOUT) + (size_t)l * DM * DM, NLAT, DM, DM, DM}; pg8::StaticOrder S; S.init(NLAT, DM, G, bid);
            EpiRes E{(l == 0 && rep_ == 0) ? F.a->in[I_X] : F.a->out, F.a->out, WSP(float, WS_CTXW), rep_ ? WSP(float, WS_CTL + MiB) : mod + 2 * DM};
            pg8::gemm_phase<EpiRes, pg8::StaticOrder, MK_GALIGN, MK_GSP2, false>(F.lds, g, S, E); }
          if (!last && rep_ == 0) { pg8::Gemm g{WSP(bf16, WS_MIX), WSP(bf16, WS_WOUT) + (size_t)l * DM * DM, MALL, DM, 256, DM}; const SplitKOrder S{64, 8, 8, 256, G, bid};
            EpiResSlab E{WSP(float, WS_SLAB), mod + 2 * DM, 256};
            pg8::gemm_phase<EpiResSlab, SplitKOrder, MK_GALIGN, MK_GSP2, false>(F.lds, g, S, E); } }
        GRID_BAR();
        PH(12) norm_phase(F, l, 1, MR, 8, F.a->out); GRID_BAR();
        PH(13) { pg8::Gemm g{WSP(bf16, WS_H), WSP(bf16, WS_WF1) + (size_t)l * F2 * DM, MR, F2, DM, DM}; pg8::StaticOrder S; S.init(MR, F2, G, bid);
          pg8::EpiBf16<0> E{WSP(bf16, WS_U), F2, nullptr, 0, 0, 1.f};
          pg8::gemm_phase<pg8::EpiBf16<0>, pg8::StaticOrder, MK_GALIGN, MK_GSP2, false>(F.lds, g, S, E); }
        GRID_BAR();
        PH(14) convact_phase(F, l, MR); GRID_BAR();
        PH(15) { { pg8::Gemm g{WSP(bf16, WS_A), WSP(bf16, WS_WF2) + (size_t)l * DM * FH, NLAT, DM, FH, FH}; pg8::StaticOrder S; S.init(NLAT, DM, G, bid);
            EpiRes E{F.a->out, F.a->out, WSP(float, WS_CTXW), rep_ ? WSP(float, WS_CTL + MiB) : mod + 5 * DM};
            pg8::gemm_phase<EpiRes, pg8::StaticOrder, MK_GALIGN, MK_GSP2, false>(F.lds, g, S, E); }
          if (!last && rep_ == 0) { pg8::Gemm g{WSP(bf16, WS_A), WSP(bf16, WS_WF2) + (size_t)l * DM * FH, MALL, DM, 512, FH}; const SplitKOrder S{64, 8, 11, 512, G, bid};
            EpiResSlab E{WSP(float, WS_SLAB), mod + 5 * DM, 512};
            pg8::gemm_phase<EpiResSlab, SplitKOrder, MK_GALIGN, MK_GSP2, false>(F.lds, g, S, E); } }
        if (!last) GRID_BAR();
    }
}

extern "C" void kernel_launch(void* const* d_in, const int* in_sizes, int n_in, void* d_out, int out_size, void* d_ws, size_t ws_size, hipStream_t stream) {
    static int grid = 0;
    if (grid == 0) {
        if (n_in != 29 || in_sizes[0] != NLAT * DM || out_size != NLAT * DM || ws_size < WS_END) {
            fprintf(stderr, "kernel_launch: built for 29 inputs, x/out of %d floats, >= %zu bytes of workspace; got n_in %d, in0 %d, out %d, ws %zu; nothing launched\n", NLAT * DM, (size_t)WS_END, n_in, n_in > 0 ? in_sizes[0] : -1, out_size, ws_size); grid = -1; return; }
        int dev = 0, cus = 0, per_cu = 0;
        if (hipGetDevice(&dev) != hipSuccess || hipDeviceGetAttribute(&cus, hipDeviceAttributeMultiprocessorCount, dev) != hipSuccess) { fprintf(stderr, "kernel_launch: device query failed\n"); grid = -1; return; }
        if (hipFuncSetAttribute((const void*)fwd_kernel, hipFuncAttributeMaxDynamicSharedMemorySize, LDS_BYTES) != hipSuccess) { fprintf(stderr, "kernel_launch: hipFuncSetAttribute failed\n"); grid = -1; return; }
        if (hipOccupancyMaxActiveBlocksPerMultiprocessor(&per_cu, (const void*)fwd_kernel, NWAVES * 64, LDS_BYTES) != hipSuccess || per_cu < 1)
            fprintf(stderr, "kernel_launch: note: occupancy query reports %d workgroups per CU\n", per_cu);
        (void)hipGetLastError();
        grid = cus;
        fprintf(stderr, "kernel_launch: grid %d, occupancy query %d\n", grid, per_cu);
    }
    if (grid < 0) return;
    if (hipMemsetAsync((char*)d_ws + WS_CTL, 0, CTL_ZERO_BYTES, stream) != hipSuccess) { fprintf(stderr, "kernel_launch: memset failed\n"); return; }
    Args a{};
    for (int i = 0; i < 29; ++i) a.in[i] = (const float*)d_in[i];
    a.out = (float*)d_out; a.ws = (unsigned char*)d_ws;
    hipLaunchKernelGGL(fwd_kernel, dim3(grid), dim3(NWAVES * 64), LDS_BYTES, stream, a);
    const hipError_t le = hipPeekAtLastError();
    if (le != hipSuccess) fprintf(stderr, "kernel_launch: launch failed: %s\n", hipGetErrorName(le));
}
```
